# Optimizing an MI355X kernel written in HIP

```python
import math
import jax
import jax.numpy as jnp
from jax import lax
import numpy as np


D_MODEL = 1024
BATCH = 16
SEQ = 2048
DEPTH = 2

N_A_LAYERS = DEPTH // 2
N_B_LAYERS = DEPTH - N_A_LAYERS

SSM_GROUP = 16
SSM_GROUPS = D_MODEL // SSM_GROUP
SSM_STATE = 64
DT_MIN = 0.001
DT_MAX = 0.1

HEAD_DIM = 64
HEADS_PER_GROUP = D_MODEL // HEAD_DIM
DILATED_GROUPS = ((128, 1), (512, 4), (2048, 16))
N_DIL = len(DILATED_GROUPS)
BAND = DILATED_GROUPS[0][0] // DILATED_GROUPS[0][1]
MAX_DIL = max(d for _, d in DILATED_GROUPS)
ATT_WIDTH = N_DIL * HEADS_PER_GROUP * HEAD_DIM
MERGED_WIDTH = HEADS_PER_GROUP * HEAD_DIM
NEG_BIG = -1e30

REL_BUCKETS = 32
REL_MAX_DIST = 2048

D_FF = 2816
CONV_WIDTH = 3

DN_ALPHA = (2.0 * DEPTH) ** 0.25
DN_BETA = (8.0 * DEPTH) ** -0.25
LN_EPS = 1e-5

kernel_name = 'yoco_s5_dilated_attn_deepnorm_trunk'


def layer_norm(x, gain, bias):
    xf = x.astype(jnp.float32)
    mu = jnp.mean(xf, axis=-1, keepdims=True)
    var = jnp.mean(jnp.square(xf - mu), axis=-1, keepdims=True)
    y = (xf - mu) * lax.rsqrt(var + LN_EPS) * gain.astype(jnp.float32) + bias.astype(jnp.float32)
    return y.astype(x.dtype)


def post_norm(x, f, gain, bias):
    return layer_norm(DN_ALPHA * x + f.astype(x.dtype), gain, bias)


def _complex_affine_combine(e1, e2):
    a1r, a1i, b1r, b1i = e1
    a2r, a2i, b2r, b2i = e2
    return (a2r * a1r - a2i * a1i,
            a2r * a1i + a2i * a1r,
            a2r * b1r - a2i * b1i + b2r,
            a2r * b1i + a2i * b1r + b2i)


def s5_mixer(x, lam_re, lam_im, log_dt, b_re, b_im, c_re, c_im, d_skip, w_glu, b_glu, w_out):
    f32 = jnp.float32
    bsz, seq, _ = x.shape
    u = x.astype(f32).reshape(bsz, seq, SSM_GROUPS, SSM_GROUP)
    lr, li = lam_re.astype(f32), lam_im.astype(f32)
    dt = jnp.exp(log_dt.astype(f32))[:, None]
    mag = jnp.exp(lr * dt)
    ab_r, ab_i = mag * jnp.cos(li * dt), mag * jnp.sin(li * dt)
    den = lr * lr + li * li
    nr = ab_r - 1.0
    co_r = (nr * lr + ab_i * li) / den
    co_i = (ab_i * lr - nr * li) / den
    br, bi = b_re.astype(f32), b_im.astype(f32)
    bb_r = co_r[..., None] * br - co_i[..., None] * bi
    bb_i = co_r[..., None] * bi + co_i[..., None] * br
    bu_r = jnp.einsum('blgh,gph->blgp', u, bb_r)
    bu_i = jnp.einsum('blgh,gph->blgp', u, bb_i)
    a_r = jnp.broadcast_to(ab_r, (1, seq, SSM_GROUPS, SSM_STATE))
    a_i = jnp.broadcast_to(ab_i, (1, seq, SSM_GROUPS, SSM_STATE))
    _, _, h_r, h_i = lax.associative_scan(_complex_affine_combine, (a_r, a_i, bu_r, bu_i), axis=1)
    y = (jnp.einsum('blgp,ghp->blgh', h_r, c_re.astype(f32))
         - jnp.einsum('blgp,ghp->blgh', h_i, c_im.astype(f32))
         + d_skip.astype(f32) * u)
    y = jax.nn.gelu(y.reshape(bsz, seq, D_MODEL))
    g = y * jax.nn.sigmoid(y @ w_glu.astype(f32) + b_glu.astype(f32))
    return (g @ w_out.astype(f32)).astype(x.dtype)


def conv_glu_ffn(x, w_up, conv_w, conv_b, w_down):
    seq = x.shape[1]
    hcat = x @ w_up
    hp = jnp.pad(hcat, ((0, 0), (CONV_WIDTH - 1, 0), (0, 0)))
    hcat = conv_b + sum(conv_w[k] * hp[:, CONV_WIDTH - 1 - k:CONV_WIDTH - 1 - k + seq]
                        for k in range(CONV_WIDTH))
    val, gate = jnp.split(hcat, 2, axis=-1)
    return (jax.nn.silu(gate) * val) @ w_down


def _padded_len(seq):
    span = BAND * MAX_DIL
    return -(-seq // span) * span


def _to_residue_blocks(t, dil):
    bsz, lp, h, e = t.shape
    m = lp // dil
    t = t.reshape(bsz, m, dil, h, e).transpose(0, 2, 1, 3, 4)
    return t.reshape(bsz, dil, m // BAND, BAND, h, e)


def _from_residue_blocks(t, dil):
    bsz = t.shape[0]
    rest = t.shape[4:]
    t = t.reshape((bsz, dil, -1) + rest)
    t = jnp.moveaxis(t, 1, 2)
    return t.reshape((bsz, -1) + rest)


def _with_previous_block(t):
    prev = jnp.concatenate([jnp.zeros_like(t[:, :, :1]), t[:, :, :-1]], axis=2)
    return jnp.concatenate([prev, t], axis=3)


def _t5_bucket(dist):
    exact = REL_BUCKETS // 2
    d = np.maximum(dist, 1).astype(np.float32)
    large = exact + (np.log(d / exact) / math.log(REL_MAX_DIST / exact)
                     * (REL_BUCKETS - exact)).astype(np.int64)
    large = np.minimum(large, REL_BUCKETS - 1)
    return np.where(dist < exact, dist, large).astype(np.int32)


def _group_bias_mask(rel_bias, g, dil, n_blocks):
    steps = np.arange(BAND)[:, None] + BAND - np.arange(2 * BAND)[None, :]
    bucket = _t5_bucket(np.maximum(steps, 0) * dil)
    cols = rel_bias[:, g * HEADS_PER_GROUP:(g + 1) * HEADS_PER_GROUP]
    bias = jnp.transpose(cols[bucket], (2, 0, 1)).astype(jnp.float32)
    in_band = (steps >= 0) & (steps <= BAND)
    has_prev = (np.arange(n_blocks)[:, None, None] > 0) | (np.arange(2 * BAND)[None, None, :] >= BAND)
    valid = jnp.asarray(in_band[None] & has_prev)
    return bias, valid


def shared_kv(h, w_kv):
    bsz, seq, _ = h.shape
    lp = _padded_len(seq)
    kv = (h @ w_kv).astype(jnp.float32)
    kv = jnp.pad(kv, ((0, 0), (0, lp - seq), (0, 0)))
    kv = kv.reshape(bsz, lp, 2, N_DIL, HEADS_PER_GROUP, HEAD_DIM)
    blocks = []
    for g, (_, dil) in enumerate(DILATED_GROUPS):
        blocks.append(_with_previous_block(_to_residue_blocks(kv[:, :, 0, g], dil)))
        blocks.append(_with_previous_block(_to_residue_blocks(kv[:, :, 1, g], dil)))
    return blocks


def dilated_attention(h, w_q, w_out, rel_bias, kv_blocks):
    bsz, seq, _ = h.shape
    lp = _padded_len(seq)
    q = (h @ w_q).astype(jnp.float32) * (HEAD_DIM ** -0.5)
    q = jnp.pad(q, ((0, 0), (0, lp - seq), (0, 0))).reshape(bsz, lp, N_DIL, HEADS_PER_GROUP, HEAD_DIM)
    outs, lses = [], []
    for g, (_, dil) in enumerate(DILATED_GROUPS):
        kb, vb = kv_blocks[2 * g], kv_blocks[2 * g + 1]
        qb = _to_residue_blocks(q[:, :, g], dil)
        bias, valid = _group_bias_mask(rel_bias, g, dil, qb.shape[2])
        s = jnp.einsum('brnqhe,brnkhe->brnhqk', qb, kb) + bias
        s = jnp.where(valid[:, None], s, NEG_BIG)
        lse = jax.nn.logsumexp(s, axis=-1)
        p = jnp.exp(s - lse[..., None])
        o = jnp.einsum('brnhqk,brnkhe->brnqhe', p, vb)
        outs.append(_from_residue_blocks(o, dil)[:, :seq])
        lses.append(_from_residue_blocks(jnp.swapaxes(lse, -1, -2), dil)[:, :seq])
    wts = jax.nn.softmax(jnp.stack(lses), axis=0)
    o = jnp.einsum('gblh,gblhe->blhe', wts, jnp.stack(outs))
    return o.reshape(bsz, seq, MERGED_WIDTH).astype(h.dtype) @ w_out


def setup_inputs(seed: int = 0) -> dict:
    key = jax.random.key(seed)
    ks = jax.random.split(key, 24)
    f32 = jnp.float32
    na, nbl, g, p, gs = N_A_LAYERS, N_B_LAYERS, SSM_GROUPS, SSM_STATE, SSM_GROUP

    def nrm(k, shape, scale):
        return jax.random.normal(k, shape, f32) * scale

    x = nrm(ks[0], (BATCH, SEQ, D_MODEL), 1.0)
    s5_lam_re = -0.5 + nrm(ks[1], (na, g, p), 0.01)
    s5_lam_im = math.pi * jnp.arange(p, dtype=f32) + nrm(ks[2], (na, g, p), 0.01)
    s5_log_dt = jax.random.uniform(ks[3], (na, g), f32, math.log(DT_MIN), math.log(DT_MAX))
    s5_b_re = nrm(ks[4], (na, g, p, gs), (2.0 * gs) ** -0.5)
    s5_b_im = nrm(ks[5], (na, g, p, gs), (2.0 * gs) ** -0.5)
    s5_c_re = nrm(ks[6], (na, g, gs, p), p ** -0.5)
    s5_c_im = nrm(ks[7], (na, g, gs, p), p ** -0.5)
    s5_d = nrm(ks[8], (na, g, gs), 1.0)
    s5_w_glu = nrm(ks[9], (na, D_MODEL, D_MODEL), D_MODEL ** -0.5)
    s5_b_glu = nrm(ks[10], (na, D_MODEL), 0.01)
    s5_w_out = nrm(ks[11], (na, D_MODEL, D_MODEL), D_MODEL ** -0.5 * DN_BETA)
    w_k = nrm(ks[12], (D_MODEL, ATT_WIDTH), D_MODEL ** -0.5)
    w_v = nrm(ks[13], (D_MODEL, ATT_WIDTH), D_MODEL ** -0.5 * DN_BETA)
    attn_w_kv = jnp.concatenate([w_k, w_v], axis=1)
    attn_w_q = nrm(ks[14], (nbl, D_MODEL, ATT_WIDTH), D_MODEL ** -0.5)
    attn_w_out = nrm(ks[15], (nbl, MERGED_WIDTH, D_MODEL), MERGED_WIDTH ** -0.5 * DN_BETA)
    rel_bias = nrm(ks[16], (REL_BUCKETS, N_DIL * HEADS_PER_GROUP), 0.5)
    ffn_w_up = nrm(ks[17], (DEPTH, D_MODEL, 2 * D_FF), D_MODEL ** -0.5 * DN_BETA)
    ffn_conv_w = nrm(ks[18], (DEPTH, CONV_WIDTH, 2 * D_FF), CONV_WIDTH ** -0.5)
    ffn_conv_b = nrm(ks[19], (DEPTH, 2 * D_FF), 0.01)
    ffn_w_down = nrm(ks[20], (DEPTH, D_FF, D_MODEL), D_FF ** -0.5 * DN_BETA)
    ln_gain = 1.0 + nrm(ks[21], (DEPTH, 2, D_MODEL), 0.01)
    ln_bias = nrm(ks[22], (DEPTH, 2, D_MODEL), 0.01)
    return {'x': x, 's5_lam_re': s5_lam_re, 's5_lam_im': s5_lam_im, 's5_log_dt': s5_log_dt,
            's5_b_re': s5_b_re, 's5_b_im': s5_b_im, 's5_c_re': s5_c_re, 's5_c_im': s5_c_im,
            's5_d': s5_d, 's5_w_glu': s5_w_glu, 's5_b_glu': s5_b_glu, 's5_w_out': s5_w_out,
            'attn_w_kv': attn_w_kv, 'attn_w_q': attn_w_q, 'attn_w_out': attn_w_out,
            'rel_bias': rel_bias, 'ffn_w_up': ffn_w_up, 'ffn_conv_w': ffn_conv_w,
            'ffn_conv_b': ffn_conv_b, 'ffn_w_down': ffn_w_down, 'ln_gain': ln_gain, 'ln_bias': ln_bias}


def reference(x, s5_lam_re, s5_lam_im, s5_log_dt, s5_b_re, s5_b_im, s5_c_re, s5_c_im,
              s5_d, s5_w_glu, s5_b_glu, s5_w_out, attn_w_kv, attn_w_q, attn_w_out,
              rel_bias, ffn_w_up, ffn_conv_w, ffn_conv_b, ffn_w_down, ln_gain, ln_bias):
    h = x
    kv_blocks = None
    for layer in range(DEPTH):
        if layer < N_A_LAYERS:
            i = layer
            mix = s5_mixer(h, s5_lam_re[i], s5_lam_im[i], s5_log_dt[i], s5_b_re[i], s5_b_im[i],
                           s5_c_re[i], s5_c_im[i], s5_d[i], s5_w_glu[i], s5_b_glu[i], s5_w_out[i])
        else:
            j = layer - N_A_LAYERS
            mix = dilated_attention(h, attn_w_q[j], attn_w_out[j], rel_bias, kv_blocks)
        h = post_norm(h, mix, ln_gain[layer, 0], ln_bias[layer, 0])
        ffn = conv_glu_ffn(h, ffn_w_up[layer], ffn_conv_w[layer], ffn_conv_b[layer], ffn_w_down[layer])
        h = post_norm(h, ffn, ln_gain[layer, 1], ln_bias[layer, 1])
        if layer == N_A_LAYERS - 1:
            kv_blocks = shared_kv(h, attn_w_kv)
    return h
```

```cpp
#include <hip/hip_runtime.h>
#include <cstdint>
#include <cstdio>

namespace nv {
constexpr int B = 16, L = 2048, D = 1024, M = B * L;
constexpr int G = 64, GS = 16, P = 64;
constexpr int FF = 2816, FF2 = 5632;
constexpr int AW = 3072, HD = 64, NH = 16;
constexpr float ALPHA = 1.4142135623730951f;
constexpr float LN_EPS = 1e-5f;

__device__ const unsigned char BUCKET[3][129] = {
{0,1,2,3,4,5,6,7,8,9,10,11,12,13,14,15,16,16,16,16,16,16,17,17,17,17,17,17,17,17,18,18,18,18,18,18,18,18,18,18,19,19,19,19,19,19,19,19,19,19,19,19,19,19,20,20,20,20,20,20,20,20,20,20,20,20,20,20,20,20,20,20,20,21,21,21,21,21,21,21,21,21,21,21,21,21,21,21,21,21,21,21,21,21,21,21,21,21,21,22,22,22,22,22,22,22,22,22,22,22,22,22,22,22,22,22,22,22,22,22,22,22,22,22,22,22,22,22,22},
{0,4,8,12,16,16,17,17,18,18,19,19,19,19,20,20,20,20,20,21,21,21,21,21,21,22,22,22,22,22,22,22,22,22,23,23,23,23,23,23,23,23,23,23,23,23,24,24,24,24,24,24,24,24,24,24,24,24,24,24,24,24,25,25,25,25,25,25,25,25,25,25,25,25,25,25,25,25,25,25,25,25,25,26,26,26,26,26,26,26,26,26,26,26,26,26,26,26,26,26,26,26,26,26,26,26,26,26,26,26,26,26,26,27,27,27,27,27,27,27,27,27,27,27,27,27,27,27,27},
{0,16,18,19,20,21,21,22,22,23,23,23,24,24,24,24,25,25,25,25,25,26,26,26,26,26,26,26,26,27,27,27,27,27,27,27,27,27,27,28,28,28,28,28,28,28,28,28,28,28,28,28,29,29,29,29,29,29,29,29,29,29,29,29,29,29,29,29,29,29,30,30,30,30,30,30,30,30,30,30,30,30,30,30,30,30,30,30,30,30,30,30,30,30,30,31,31,31,31,31,31,31,31,31,31,31,31,31,31,31,31,31,31,31,31,31,31,31,31,31,31,31,31,31,31,31,31,31,31}};

__device__ __forceinline__ double d_exp_small(double x) {
    double y = x * 0.125, t = 1.0, s = 1.0;
#pragma unroll
    for (int i = 1; i <= 14; ++i) { t *= y / (double)i; s += t; }
    s *= s; s *= s; s *= s; return s;
}
__device__ __forceinline__ void d_sincos(double x, double& sn, double& cs) {
    const double TWO_PI = 6.283185307179586476925286766559;
    double k = __builtin_rint(x / TWO_PI); double r = x - k * TWO_PI;
    double q = r * 0.25, q2 = q * q;
    double s = 0.0, c = 0.0, ts = q, tc = 1.0;
#pragma unroll
    for (int i = 0; i < 10; ++i) { s += ts; c += tc; ts *= -q2 / (double)((2 * i + 2) * (2 * i + 3)); tc *= -q2 / (double)((2 * i + 1) * (2 * i + 2)); }
#pragma unroll
    for (int i = 0; i < 2; ++i) { double s2 = 2.0 * s * c, c2 = c * c - s * s; s = s2; c = c2; }
    sn = s; cs = c;
}
__device__ __forceinline__ float gelu_tanh(float v) {
    const float z2 = 1.5957691216057308f * (v + 0.044715f * v * v * v);
    return v / (1.0f + __expf(-z2));
}
__device__ __forceinline__ float sigmoidf(float v) { return 1.0f / (1.0f + __expf(-v)); }

__global__ void __launch_bounds__(64) s5_naive(const float* __restrict__ x, const float* lam_re, const float* lam_im, const float* log_dt,
                                               const float* b_re, const float* b_im, const float* c_re, const float* c_im, const float* dsk, float* __restrict__ Y) {
    const int b = blockIdx.x / G, g = blockIdx.x % G, p = threadIdx.x;
    __shared__ float hs[2][64];
    __shared__ float cr[16][65], ci[16][65];
    for (int i = p; i < 16 * 64; i += 64) { cr[i / 64][i % 64] = c_re[g * 1024 + i]; ci[i / 64][i % 64] = c_im[g * 1024 + i]; }
    const double dt = d_exp_small((double)log_dt[g] * 0.5); const double dtt = dt * dt;
    const double lr = lam_re[g * P + p], li = lam_im[g * P + p];
    const double mag = d_exp_small(lr * dtt); double sn, cs; d_sincos(li * dtt, sn, cs);
    const double abr = mag * cs, abi = mag * sn, den = lr * lr + li * li, nr = abr - 1.0;
    const double cor = (nr * lr + abi * li) / den, coi = (abi * lr - nr * li) / den;
    float bbr[16], bbi[16];
#pragma unroll
    for (int h = 0; h < 16; ++h) { const double br = b_re[(g * P + p) * 16 + h], bi = b_im[(g * P + p) * 16 + h]; bbr[h] = (float)(cor * br - coi * bi); bbi[h] = (float)(cor * bi + coi * br); }
    const float ar = (float)abr, ai = (float)abi;
    const float dsk_l = p < 16 ? dsk[g * 16 + p] : 0.f;
    float hr = 0.f, hi = 0.f;
    __syncthreads();
    for (int t = 0; t < L; ++t) {
        const float* ur = x + ((size_t)(b * L + t)) * D + g * 16;
        float u[16];
#pragma unroll
        for (int h = 0; h < 16; ++h) u[h] = ur[h];
        float sr = 0.f, si = 0.f;
#pragma unroll
        for (int h = 0; h < 16; ++h) { sr += bbr[h] * u[h]; si += bbi[h] * u[h]; }
        const float nhr = ar * hr - ai * hi + sr, nhi = ar * hi + ai * hr + si;
        hr = nhr; hi = nhi;
        hs[0][p] = hr; hs[1][p] = hi;
        __syncthreads();
        if (p < 16) {
            float y = 0.f;
            for (int q = 0; q < 64; ++q) y += cr[p][q] * hs[0][q] - ci[p][q] * hs[1][q];
            y += dsk_l * ur[p];
            Y[((size_t)(b * L + t)) * D + g * 16 + p] = gelu_tanh(y);
        }
        __syncthreads();
    }
}

struct EpiGlu { const float* Y; const float* bglu; float* Gout; __device__ void operator()(int r, int c, float acc) const { const float y = Y[(size_t)r * D + c]; Gout[(size_t)r * D + c] = y * sigmoidf(acc + bglu[c]); } };
struct EpiRes { const float* R; float* Z; __device__ void operator()(int r, int c, float acc) const { Z[(size_t)r * D + c] = ALPHA * R[(size_t)r * D + c] + acc; } };
struct EpiStore { float* C; int ldc; float scale; __device__ void operator()(int r, int c, float acc) const { C[(size_t)r * ldc + c] = acc * scale; } };

template <class Epi> __global__ void __launch_bounds__(256) gemm_naive(const float* __restrict__ A, int lda, const float* __restrict__ W, int ldw, int K, int row_out0, Epi epi) {
    __shared__ float As[16][68], Bs[16][68];
    const int tid = threadIdx.x, tx = tid & 15, ty = tid >> 4;
    const int r0 = blockIdx.y * 64, c0 = blockIdx.x * 64;
    float acc[4][4] = {};
    for (int k0 = 0; k0 < K; k0 += 16) {
        { const int rr = tid >> 2, kk = (tid & 3) * 4; const float4 v = *(const float4*)(A + (size_t)(r0 + rr) * lda + k0 + kk); As[kk][rr] = v.x; As[kk + 1][rr] = v.y; As[kk + 2][rr] = v.z; As[kk + 3][rr] = v.w; }
        { const int kk = tid >> 4, cc = (tid & 15) * 4; const float4 v = *(const float4*)(W + (size_t)(k0 + kk) * ldw + c0 + cc); *(float4*)&Bs[kk][cc] = v; }
        __syncthreads();
#pragma unroll
        for (int k = 0; k < 16; ++k) {
            float a[4], bb[4];
#pragma unroll
            for (int i = 0; i < 4; ++i) { a[i] = As[k][ty * 4 + i]; bb[i] = Bs[k][tx * 4 + i]; }
#pragma unroll
            for (int i = 0; i < 4; ++i)
#pragma unroll
                for (int j = 0; j < 4; ++j) acc[i][j] += a[i] * bb[j];
        }
        __syncthreads();
    }
#pragma unroll
    for (int i = 0; i < 4; ++i)
#pragma unroll
        for (int j = 0; j < 4; ++j) epi(row_out0 + r0 + ty * 4 + i, c0 + tx * 4 + j, acc[i][j]);
}

__global__ void __launch_bounds__(256) ln_naive(float* Z, const float* gain, const float* bias) {
    const int row = blockIdx.x * 4 + (threadIdx.x >> 6), lane = threadIdx.x & 63;
    float* z = Z + (size_t)row * D; float v[16]; float s = 0.f;
#pragma unroll
    for (int i = 0; i < 16; ++i) { v[i] = z[lane + 64 * i]; s += v[i]; }
#pragma unroll
    for (int o = 1; o < 64; o <<= 1) s += __shfl_xor(s, o);
    const float mu = s * (1.0f / D); float q = 0.f;
#pragma unroll
    for (int i = 0; i < 16; ++i) { v[i] -= mu; q += v[i] * v[i]; }
#pragma unroll
    for (int o = 1; o < 64; o <<= 1) q += __shfl_xor(q, o);
    const float rstd = 1.0f / sqrtf(q * (1.0f / D) + LN_EPS);
#pragma unroll
    for (int i = 0; i < 16; ++i) { const int c = lane + 64 * i; z[c] = v[i] * rstd * gain[c] + bias[c]; }
}

__global__ void __launch_bounds__(256) convgate_naive(const float* __restrict__ HC, const float* cw, const float* cb, float* __restrict__ ACT, int rows) {
    const size_t i = (size_t)blockIdx.x * 256 + threadIdx.x; if (i >= (size_t)rows * FF) return;
    const int r = (int)(i / FF), c = (int)(i % FF), t = r % L;
    float val = cb[c], gate = cb[c + FF];
#pragma unroll
    for (int k = 0; k < 3; ++k) if (t - k >= 0) { val += cw[k * FF2 + c] * HC[(size_t)(r - k) * FF2 + c]; gate += cw[k * FF2 + c + FF] * HC[(size_t)(r - k) * FF2 + c + FF]; }
    ACT[i] = gate * sigmoidf(gate) * val;
}

__global__ void __launch_bounds__(64) attn_naive(const float* __restrict__ KV, const float* __restrict__ Q, const float* __restrict__ rel_bias, float* __restrict__ O, int rows, int row_out0) {
    const int idx = blockIdx.x * 64 + threadIdx.x; if (idx >= rows * NH) return;
    const int h = idx / rows, r = idx % rows, t = r % L;
    float o[64]; float m = -1e30f, l = 0.f;
#pragma unroll
    for (int e = 0; e < 64; ++e) o[e] = 0.f;
    for (int g = 0; g < 3; ++g) {
        const int dil = g == 0 ? 1 : (g == 1 ? 4 : 16);
        float q[64];
        const float* qp = Q + (size_t)r * AW + g * 1024 + h * 64;
#pragma unroll
        for (int e = 0; e < 64; ++e) q[e] = qp[e];
        for (int s = 0; s <= 128; ++s) {
            if (t - s * dil < 0) break;
            const float* kp = KV + (size_t)(r - s * dil) * 6144 + g * 1024 + h * 64; const float* vp = kp + 3072;
            float sc = 0.f;
#pragma unroll
            for (int e = 0; e < 64; ++e) sc += q[e] * kp[e];
            sc += rel_bias[BUCKET[g][s] * 48 + g * 16 + h];
            if (sc > m) { const float f = __expf(m - sc); l *= f;
#pragma unroll
                for (int e = 0; e < 64; ++e) o[e] *= f;
                m = sc; }
            const float pexp = __expf(sc - m); l += pexp;
#pragma unroll
            for (int e = 0; e < 64; ++e) o[e] += pexp * vp[e];
        }
    }
    const float inv = 1.0f / l; float* op = O + (size_t)(row_out0 + r) * D + h * 64;
#pragma unroll
    for (int e = 0; e < 64; ++e) op[e] = o[e] * inv;
}
}

extern "C" void kernel_launch(void* const* d_in, const int* in_sizes, int n_in, void* d_out, int out_size, void* d_ws, size_t ws_size, hipStream_t stream) {
    using namespace nv;
    const float* x = (const float*)d_in[0];
    const float *lam_re = (const float*)d_in[1], *lam_im = (const float*)d_in[2], *log_dt = (const float*)d_in[3], *b_re = (const float*)d_in[4], *b_im = (const float*)d_in[5];
    const float *c_re = (const float*)d_in[6], *c_im = (const float*)d_in[7], *dsk = (const float*)d_in[8], *w_glu = (const float*)d_in[9], *b_glu = (const float*)d_in[10], *w_out = (const float*)d_in[11];
    const float *w_kv = (const float*)d_in[12], *w_q = (const float*)d_in[13], *w_ao = (const float*)d_in[14], *rel_bias = (const float*)d_in[15];
    const float *w_up = (const float*)d_in[16], *conv_w = (const float*)d_in[17], *conv_b = (const float*)d_in[18], *w_down = (const float*)d_in[19], *ln_g = (const float*)d_in[20], *ln_b = (const float*)d_in[21];
    float* out = (float*)d_out; char* ws = (char*)d_ws;
    const size_t MiB = 1u << 20;
    constexpr int CH = 8192;
    float* Y = (float*)(ws); float* Gb = (float*)(ws + 128 * MiB);
    hipLaunchKernelGGL(s5_naive, dim3(B * G), dim3(64), 0, stream, x, lam_re, lam_im, log_dt, b_re, b_im, c_re, c_im, dsk, Y);
    hipLaunchKernelGGL(gemm_naive<EpiGlu>, dim3(D / 64, M / 64), dim3(256), 0, stream, Y, D, w_glu, D, D, 0, EpiGlu{Y, b_glu, Gb});
    hipLaunchKernelGGL(gemm_naive<EpiRes>, dim3(D / 64, M / 64), dim3(256), 0, stream, Gb, D, w_out, D, D, 0, EpiRes{x, out});
    hipLaunchKernelGGL(ln_naive, dim3(M / 4), dim3(256), 0, stream, out, ln_g + 0 * D, ln_b + 0 * D);
    for (int layer = 0; layer < 2; ++layer) {
        if (layer == 1) {
            float* KVb = (float*)ws; float* Qb = (float*)(ws + 192 * MiB); float* Ob = (float*)(ws + 288 * MiB);
            for (int c = 0; c < M / CH; ++c) {
                const float* Hc = out + (size_t)c * CH * D;
                hipLaunchKernelGGL(gemm_naive<EpiStore>, dim3(6144 / 64, CH / 64), dim3(256), 0, stream, Hc, D, w_kv, 6144, D, 0, EpiStore{KVb, 6144, 1.0f});
                hipLaunchKernelGGL(gemm_naive<EpiStore>, dim3(AW / 64, CH / 64), dim3(256), 0, stream, Hc, D, w_q, AW, D, 0, EpiStore{Qb, AW, 0.125f});
                hipLaunchKernelGGL(attn_naive, dim3(CH * NH / 64), dim3(64), 0, stream, KVb, Qb, rel_bias, Ob, CH, c * CH);
            }
            hipLaunchKernelGGL(gemm_naive<EpiRes>, dim3(D / 64, M / 64), dim3(256), 0, stream, Ob, D, w_ao, D, D, 0, EpiRes{out, out});
            hipLaunchKernelGGL(ln_naive, dim3(M / 4), dim3(256), 0, stream, out, ln_g + 2 * D, ln_b + 2 * D);
        }
        float* HC = (float*)ws; float* ACT = (float*)(ws + 176 * MiB);
        for (int c = 0; c < M / CH; ++c) {
            float* Hc = out + (size_t)c * CH * D;
            hipLaunchKernelGGL(gemm_naive<EpiStore>, dim3(FF2 / 64, CH / 64), dim3(256), 0, stream, Hc, D, w_up + (size_t)layer * D * FF2, FF2, D, 0, EpiStore{HC, FF2, 1.0f});
            hipLaunchKernelGGL(convgate_naive, dim3((unsigned)(((size_t)CH * FF + 255) / 256)), dim3(256), 0, stream, HC, conv_w + (size_t)layer * 3 * FF2, conv_b + (size_t)layer * FF2, ACT, CH);
            hipLaunchKernelGGL(gemm_naive<EpiRes>, dim3(D / 64, CH / 64), dim3(256), 0, stream, ACT, FF, w_down + (size_t)layer * FF * D, D, FF, c * CH, EpiRes{out, out});
        }
        hipLaunchKernelGGL(ln_naive, dim3(M / 4), dim3(256), 0, stream, out, ln_g + (layer * 2 + 1) * D, ln_b + (layer * 2 + 1) * D);
    }
}
```

```cpp
#include <hip/hip_runtime.h>
#include <cstdio>
#include <cstdint>
namespace pg8 {
#define PG8_LAS __attribute__((address_space(3)))
typedef unsigned short bf16_t;
typedef short bf16x8 __attribute__((ext_vector_type(8)));
typedef float f32x4 __attribute__((ext_vector_type(4)));
typedef unsigned u32x4 __attribute__((ext_vector_type(4)));
constexpr int BM = 256, BK = 64, HALF = 128, HTB = HALF * BK * 2  , STAGE_BYTES = 8 * HTB, NXCD = 8, WGM = 8;

__host__ __device__ __forceinline__ int lds_byte(int r, int c) { const int st = (r >> 4) * 2 + (c >> 5), rr = r & 15, cc = c & 31, ob = rr * 64 + cc * 2; return st * 1024 + (ob ^ (((ob >> 9) & 1) << 5)); }
__host__ __device__ __forceinline__ void stage_rc(int b, int& R, int& C) { const int st = b / 1024, sb = b % 1024, swz = sb ^ (((sb >> 9) & 1) << 5); R = (st >> 1) * 16 + swz / 64; C = (st & 1) * 32 + (swz % 64) / 2; }
__host__ __device__ __forceinline__ int perm32(int rho) { const int n = rho >> 4, i = rho & 15; return 8 * (i >> 2) + 4 * n + (i & 3); }

struct Unit { int pm, pn; };
struct Gemm { const bf16_t* A; const bf16_t* Bt; int M, N, K; };

struct StaticOrder {
    int nM, nN, nwg, G, c;
    __host__ __device__ void init(int M, int N, int G_, int c_) { nM = M / BM; nN = N / BM; nwg = nM * nN; G = G_; c = c_; }
    __host__ __device__ bool next(int i, Unit& u) const {
        const long L = (long)i * G + c; if (L >= nwg) return false;
        int wgid = (int)L; { const int q = nwg / NXCD, r = nwg % NXCD, xcd = wgid % NXCD, off = wgid / NXCD; wgid = (xcd < r ? xcd * (q + 1) : r * (q + 1) + (xcd - r) * q) + off; }
        const int nig = WGM * nN, gid = wgid / nig, fm = gid * WGM, gsz = (nM - fm) < WGM ? (nM - fm) : WGM;
        u.pm = fm + ((wgid % nig) % gsz); u.pn = (wgid % nig) / gsz; return true;
    }
    __device__ __forceinline__ void a_ready(const Unit&) const {}
    __device__ __forceinline__ void done(const Unit&) const {}
};
__device__ __forceinline__ unsigned cvt_pk_bf16(float lo, float hi) { unsigned r; asm volatile("v_cvt_pk_bf16_f32 %0, %1, %2" : "=v"(r) : "v"(lo), "v"(hi)); return r; }

__device__ __forceinline__ float bf_lo(unsigned u) { return __uint_as_float(u << 16); }
__device__ __forceinline__ float bf_hi(unsigned u) { return __uint_as_float(u & 0xffff0000u); }
__device__ __forceinline__ float fast_sigmoid(float v) { return __builtin_amdgcn_rcpf(1.0f + __expf(-v)); }
template <int CTRL> __device__ __forceinline__ float dpp_mov(float old, float src) {
    return __uint_as_float((unsigned)__builtin_amdgcn_update_dpp((int)__float_as_uint(old), (int)__float_as_uint(src), CTRL, 0xf, 0xf, false));
}
constexpr int DPP_SHR1 = 0x111, DPP_SHR2 = 0x112, DPP_ROR1 = 0x121, DPP_ROR2 = 0x122;

struct EpiGlu {
    static constexpr bool PERM = true, AFTER_DRAIN = false;
    const bf16_t* Y; const float* bias; bf16_t* O; int ldc;
    __device__ __forceinline__ void operator()(const f32x4 (&acc)[2][2][4][2], const Unit& u, int wr, int wc, int fr, int fq) const {
        const int row0 = u.pm * BM + wr * 64 + fr, col0 = u.pn * BM + wc * 32 + 8 * fq;
        f32x4 bv[2][2];
#pragma unroll
        for (int bj = 0; bj < 2; ++bj)
#pragma unroll
            for (int n = 0; n < 2; ++n) bv[bj][n] = *(const f32x4*)(bias + col0 + bj * HALF + 4 * n);
#pragma unroll
        for (int ai = 0; ai < 2; ++ai)
#pragma unroll
            for (int m = 0; m < 4; ++m) { const size_t off = (size_t)(row0 + ai * HALF + m * 16) * ldc + col0;
#pragma unroll
                for (int bj = 0; bj < 2; ++bj) { const u32x4 yv = *(const u32x4*)(Y + off + bj * HALF);
                    const f32x4 v0 = acc[ai][bj][m][0] + bv[bj][0], v1 = acc[ai][bj][m][1] + bv[bj][1];
                    u32x4 w;
                    w.x = cvt_pk_bf16(bf_lo(yv.x) * fast_sigmoid(v0[0]), bf_hi(yv.x) * fast_sigmoid(v0[1]));
                    w.y = cvt_pk_bf16(bf_lo(yv.y) * fast_sigmoid(v0[2]), bf_hi(yv.y) * fast_sigmoid(v0[3]));
                    w.z = cvt_pk_bf16(bf_lo(yv.z) * fast_sigmoid(v1[0]), bf_hi(yv.z) * fast_sigmoid(v1[1]));
                    w.w = cvt_pk_bf16(bf_lo(yv.w) * fast_sigmoid(v1[2]), bf_hi(yv.w) * fast_sigmoid(v1[3]));
                    *(u32x4*)(O + off + bj * HALF) = w; }
                asm volatile("" ::: "memory"); }
    }
};
struct EpiRes {
    static constexpr bool PERM = false, AFTER_DRAIN = false;
    const float* R; float* Z; int ldc; float alpha;
    __device__ __forceinline__ void operator()(const f32x4 (&acc)[2][2][4][2], const Unit& u, int wr, int wc, int fr, int fq) const {
        const int row0 = u.pm * BM + wr * 64 + fr, col0 = u.pn * BM + wc * 32 + 4 * fq;
#pragma unroll
        for (int ai = 0; ai < 2; ++ai)
#pragma unroll
            for (int m = 0; m < 4; ++m) { const size_t off = (size_t)(row0 + ai * HALF + m * 16) * ldc + col0;
                f32x4 r[2][2];
#pragma unroll
                for (int bj = 0; bj < 2; ++bj)
#pragma unroll
                    for (int n = 0; n < 2; ++n) r[bj][n] = *(const f32x4*)(R + off + bj * HALF + n * 16);
#pragma unroll
                for (int bj = 0; bj < 2; ++bj)
#pragma unroll
                    for (int n = 0; n < 2; ++n) *(f32x4*)(Z + off + bj * HALF + n * 16) = r[bj][n] * alpha + acc[ai][bj][m][n];
                asm volatile("" ::: "memory"); }
    }
};
struct EpiKVQ {
    static constexpr bool PERM = true, AFTER_DRAIN = false;
    bf16_t* O; int ldc; int qcol0; float qscale;
    __device__ __forceinline__ void operator()(const f32x4 (&acc)[2][2][4][2], const Unit& u, int wr, int wc, int fr, int fq) const {
        const int row0 = u.pm * BM + wr * 64 + fr, colt = u.pn * BM, col0 = colt + wc * 32 + 8 * fq; const float sc = colt >= qcol0 ? qscale : 1.0f;
#pragma unroll
        for (int ai = 0; ai < 2; ++ai)
#pragma unroll
            for (int m = 0; m < 4; ++m) { bf16_t* rowp = O + (size_t)(row0 + ai * HALF + m * 16) * ldc + col0;
#pragma unroll
                for (int bj = 0; bj < 2; ++bj) { const f32x4 v0 = acc[ai][bj][m][0] * sc, v1 = acc[ai][bj][m][1] * sc; u32x4 w;
                    w.x = cvt_pk_bf16(v0[0], v0[1]); w.y = cvt_pk_bf16(v0[2], v0[3]); w.z = cvt_pk_bf16(v1[0], v1[1]); w.w = cvt_pk_bf16(v1[2], v1[3]);
                    *(u32x4*)(rowp + bj * HALF) = w; } }
    }
};
struct EpiConvGate {
    static constexpr bool PERM = true, AFTER_DRAIN = false;
    static constexpr int FFD = 2816;
    bf16_t* ACT; const float* cw; const float* cb; float* RAW; PG8_LAS float* X;
    __device__ __forceinline__ void operator()(f32x4 (&acc)[2][2][4][2], const Unit& u, int wr, int wc, int fr, int fq) const {
        const int cl0 = wc * 32 + 8 * fq;
        const int ncol = u.pn * BM + cl0;
        const int cv = u.pn * HALF + cl0;
        if (fr >= 14) {
#pragma unroll
            for (int ai = 0; ai < 2; ++ai) { PG8_LAS float* xp = X + ((((ai * 2 + wr) * 4 + wc) * 2 + (fr - 14)) * 4 + fq) * 16;
#pragma unroll
                for (int bj = 0; bj < 2; ++bj)
#pragma unroll
                    for (int n = 0; n < 2; ++n) *(PG8_LAS f32x4*)(xp + (bj * 2 + n) * 4) = acc[ai][bj][3][n]; }
        }
        if (wr == 0 && fr < 2) { float* rp = RAW + (size_t)(u.pm * 4 + fr) * (2 * FFD) + ncol;
#pragma unroll
            for (int bj = 0; bj < 2; ++bj)
#pragma unroll
                for (int n = 0; n < 2; ++n) *(f32x4*)(rp + bj * HALF + 4 * n) = acc[0][bj][0][n]; }
        if (wr == 1 && fr >= 14) { float* rp = RAW + (size_t)(u.pm * 4 + 2 + (fr - 14)) * (2 * FFD) + ncol;
#pragma unroll
            for (int bj = 0; bj < 2; ++bj)
#pragma unroll
                for (int n = 0; n < 2; ++n) *(f32x4*)(rp + bj * HALF + 4 * n) = acc[1][bj][3][n]; }
        asm volatile("s_waitcnt lgkmcnt(0)" ::: "memory"); __builtin_amdgcn_s_barrier(); asm volatile("" ::: "memory");
        const bool skip01 = (u.pm & 7) != 0;
#pragma unroll
        for (int bj = 0; bj < 2; ++bj)
#pragma unroll
            for (int n = 0; n < 2; ++n) {
                const f32x4 bsv = *(const f32x4*)(cb + bj * FFD + cv + 4 * n);
                const f32x4 w0 = *(const f32x4*)(cw + bj * FFD + cv + 4 * n), w1 = *(const f32x4*)(cw + (2 * FFD) + bj * FFD + cv + 4 * n), w2 = *(const f32x4*)(cw + 2 * (2 * FFD) + bj * FFD + cv + 4 * n);
#pragma unroll
                for (int ai = 0; ai < 2; ++ai) {
                    const int bi = ai * 2 + wr;
                    f32x4 vb = (f32x4){0.f, 0.f, 0.f, 0.f};
                    if (bi != 0) vb = *(const PG8_LAS f32x4*)(X + (((((bi - 1) * 4 + wc) * 2 + (fr & 1)) * 4 + fq)) * 16 + (bj * 2 + n) * 4);
#pragma unroll
                    for (int m = 3; m >= 0; --m) { f32x4 o;
#pragma unroll
                        for (int e = 0; e < 4; ++e) { const float cur = acc[ai][bj][m][n][e], prv = (m == 0) ? vb[e] : acc[ai][bj][m == 0 ? 0 : m - 1][n][e];
                            const float p1 = dpp_mov<DPP_SHR1>(dpp_mov<DPP_ROR1>(0.f, prv), cur), p2 = dpp_mov<DPP_SHR2>(dpp_mov<DPP_ROR2>(0.f, prv), cur);
                            o[e] = bsv[e] + w0[e] * cur + w1[e] * p1 + w2[e] * p2; }
                        acc[ai][bj][m][n] = o; asm volatile("" : "+v"(acc[ai][bj][m][n])); }
                }
                asm volatile("" ::: "memory");
            }
#pragma unroll
        for (int ai = 0; ai < 2; ++ai)
#pragma unroll
            for (int m = 0; m < 4; ++m) {
                u32x4 pk;
                { const f32x4 v0 = acc[ai][0][m][0], v1 = acc[ai][0][m][1], g0 = acc[ai][1][m][0], g1 = acc[ai][1][m][1];
                  pk.x = cvt_pk_bf16(g0[0] * fast_sigmoid(g0[0]) * v0[0], g0[1] * fast_sigmoid(g0[1]) * v0[1]);
                  pk.y = cvt_pk_bf16(g0[2] * fast_sigmoid(g0[2]) * v0[2], g0[3] * fast_sigmoid(g0[3]) * v0[3]);
                  pk.z = cvt_pk_bf16(g1[0] * fast_sigmoid(g1[0]) * v1[0], g1[1] * fast_sigmoid(g1[1]) * v1[1]);
                  pk.w = cvt_pk_bf16(g1[2] * fast_sigmoid(g1[2]) * v1[2], g1[3] * fast_sigmoid(g1[3]) * v1[3]); }
                const int row = u.pm * BM + ai * HALF + wr * 64 + m * 16 + fr;
                if (!(skip01 && ai == 0 && wr == 0 && m == 0 && fr < 2)) *(u32x4*)(ACT + (size_t)row * FFD + cv) = pk;
            }
        asm volatile("s_waitcnt lgkmcnt(0)" ::: "memory"); __builtin_amdgcn_s_barrier(); asm volatile("" ::: "memory");
    }
};

template <class Epi, class Sched, bool ALIGN_EPI = false, bool SP2 = false>
__device__ __forceinline__ void gemm_phase(PG8_LAS unsigned char* lds, const Gemm g, const Sched& S, const Epi& E, const int tid  ) {
    const int wid = __builtin_amdgcn_readfirstlane(tid >> 6), lane = tid & 63, wr = wid >> 2, wc = wid & 3, fr = lane & 15, fq = lane >> 4;
    const int K = g.K, nt = K / BK;
    unsigned voffA[2], voffB[2];
#pragma unroll
    for (int i = 0; i < 2; ++i) { int R, C; stage_rc(tid * 16 + i * 8192, R, C); const int Rb = Epi::PERM ? ((R & ~31) + perm32(R & 31)) : R;
        voffA[i] = (unsigned)(R * K + C) * 2u; voffB[i] = (unsigned)(Rb * K + C) * 2u; }
    const size_t kstep = (size_t)(BK * 2);
    const size_t hstep = (size_t)HALF * K * 2;
    const size_t tstep = 2 * hstep;
    const unsigned ldsw = (unsigned)wid * 1024u;
    const int aoff = lds_byte(wr * 64 + fr, fq * 8), boff = lds_byte(wc * 32 + fr, fq * 8);
#define PG8_SA(b, h) (((b) * 2 + (h)) * HTB)
#define PG8_SB(b, h) ((4 + (b) * 2 + (h)) * HTB)
#define PG8_STAGE(bufoff, gbase, voff) do { _Pragma("unroll") for (int _i = 0; _i < 2; ++_i) \
        __builtin_amdgcn_global_load_lds((const unsigned*)((const char*)(gbase) + (voff)[_i]), (PG8_LAS unsigned*)(lds + (bufoff) + ldsw + _i * 8192), 16, 0, 0); } while (0)
#define PG8_LDA(dst, b, h) do { _Pragma("unroll") for (int m = 0; m < 4; ++m) _Pragma("unroll") for (int k = 0; k < 2; ++k) dst[m][k] = *(const PG8_LAS bf16x8*)(lds + PG8_SA(b, h) + aoff + m * 2048 + k * 1024); } while (0)
#define PG8_LDB(dst, b, h) do { _Pragma("unroll") for (int n = 0; n < 2; ++n) _Pragma("unroll") for (int k = 0; k < 2; ++k) dst[n][k] = *(const PG8_LAS bf16x8*)(lds + PG8_SB(b, h) + boff + n * 2048 + k * 1024); } while (0)
#define PG8_MMA(ai, bj, At, Bt) do { __builtin_amdgcn_s_setprio(1); _Pragma("unroll") for (int m = 0; m < 4; ++m) _Pragma("unroll") for (int n = 0; n < 2; ++n) _Pragma("unroll") for (int k = 0; k < 2; ++k) \
        acc[ai][bj][m][n] = __builtin_amdgcn_mfma_f32_16x16x32_bf16(Bt[n][k], At[m][k], acc[ai][bj][m][n], 0, 0, 0); __builtin_amdgcn_s_setprio(0); } while (0)
#define PG8_WAIT_V(n) asm volatile("s_waitcnt vmcnt(" #n ")" ::: "memory")
#define PG8_WAIT_L(n) asm volatile("s_waitcnt lgkmcnt(" #n ")" ::: "memory")
#define PG8_BAR __builtin_amdgcn_s_barrier()
#define PG8_SCHED __builtin_amdgcn_sched_barrier(0)
    Unit cur, nxt; int ui = 0;
    if (!S.next(0, cur)) return;
    f32x4 acc[2][2][4][2];
#pragma unroll
    for (int a = 0; a < 2; ++a)
#pragma unroll
        for (int b = 0; b < 2; ++b)
#pragma unroll
            for (int m = 0; m < 4; ++m)
#pragma unroll
                for (int n = 0; n < 2; ++n) acc[a][b][m][n] = (f32x4){0.f, 0.f, 0.f, 0.f};
    bf16x8 At[4][2], B0[2][2], B1[2][2];
    const char* cA = (const char*)g.A + (size_t)cur.pm * tstep; const char* cB = (const char*)g.Bt + (size_t)cur.pn * tstep;
    S.a_ready(cur);
    if constexpr (SP2) {
        PG8_STAGE(PG8_SB(0, 0), cB, voffB); PG8_STAGE(PG8_SB(0, 1), cB + hstep, voffB); PG8_STAGE(PG8_SA(0, 0), cA, voffA); PG8_STAGE(PG8_SA(0, 1), cA + hstep, voffA);
        if (wr == 1) PG8_BAR;
        PG8_WAIT_V(2); PG8_BAR;
        PG8_STAGE(PG8_SB(1, 0), cB + kstep, voffB); PG8_STAGE(PG8_SA(1, 0), cA + kstep, voffA); PG8_STAGE(PG8_SB(1, 1), cB + hstep + kstep, voffB);
        PG8_WAIT_V(6); PG8_BAR;
    } else {
        PG8_STAGE(PG8_SB(0, 0), cB, voffB); PG8_STAGE(PG8_SA(0, 0), cA, voffA); PG8_STAGE(PG8_SB(0, 1), cB + hstep, voffB); PG8_STAGE(PG8_SA(0, 1), cA + hstep, voffA);
        if (wr == 1) PG8_BAR;
        PG8_WAIT_V(4); PG8_BAR;
        PG8_STAGE(PG8_SB(1, 0), cB + kstep, voffB); PG8_STAGE(PG8_SA(1, 0), cA + kstep, voffA); PG8_STAGE(PG8_SB(1, 1), cB + hstep + kstep, voffB);
        PG8_WAIT_V(6); PG8_BAR;
    }
    for (;;) {
        const bool has_next = S.next(ui + 1, nxt);
        const char* nA = has_next ? (const char*)g.A + (size_t)nxt.pm * tstep : cA; const char* nB = has_next ? (const char*)g.Bt + (size_t)nxt.pn * tstep : cB;
        for (int t = 0; t < nt; t += 2) {
            const bool last = (t == nt - 2);
            const char* a1 = cA + (size_t)(t + 1) * kstep;
            const char* a2 = last ? nA : cA + (size_t)(t + 2) * kstep; const char* b2 = last ? nB : cB + (size_t)(t + 2) * kstep;
            const char* a3 = a2 + kstep; const char* b3 = b2 + kstep;
            if (last && has_next) S.a_ready(nxt);
            if constexpr (SP2) {
            PG8_LDB(B0, 0, 0); PG8_LDB(B1, 0, 1); PG8_SCHED; PG8_LDA(At, 0, 0); PG8_STAGE(PG8_SA(1, 1), a1 + hstep, voffA);
            PG8_WAIT_V(8); PG8_WAIT_L(0); PG8_BAR; PG8_MMA(0, 0, At, B0); PG8_MMA(0, 1, At, B1); PG8_BAR; PG8_SCHED;
            PG8_LDA(At, 0, 1); PG8_STAGE(PG8_SB(0, 0), b2, voffB); PG8_STAGE(PG8_SB(0, 1), b2 + hstep, voffB); PG8_STAGE(PG8_SA(0, 0), a2, voffA);
            PG8_WAIT_V(8); PG8_WAIT_L(0); PG8_BAR; PG8_MMA(1, 0, At, B0); PG8_MMA(1, 1, At, B1); PG8_BAR; PG8_SCHED;
            PG8_LDB(B0, 1, 0); PG8_LDB(B1, 1, 1); PG8_SCHED; PG8_LDA(At, 1, 0); PG8_STAGE(PG8_SA(0, 1), a2 + hstep, voffA);
            PG8_WAIT_V(8); PG8_WAIT_L(0); PG8_BAR; PG8_MMA(0, 0, At, B0); PG8_MMA(0, 1, At, B1); PG8_BAR; PG8_SCHED;
            PG8_LDA(At, 1, 1); PG8_STAGE(PG8_SB(1, 0), b3, voffB); PG8_STAGE(PG8_SB(1, 1), b3 + hstep, voffB); PG8_STAGE(PG8_SA(1, 0), a3, voffA);
            PG8_WAIT_V(8); PG8_WAIT_L(0); PG8_BAR; PG8_MMA(1, 0, At, B0); PG8_MMA(1, 1, At, B1); PG8_BAR; PG8_SCHED;
            } else {
            PG8_LDB(B0, 0, 0); PG8_SCHED; PG8_LDA(At, 0, 0); PG8_STAGE(PG8_SA(1, 1), a1 + hstep, voffA);
            PG8_WAIT_L(8); PG8_BAR; PG8_WAIT_L(0); PG8_MMA(0, 0, At, B0); PG8_BAR; PG8_SCHED;
            PG8_LDB(B1, 0, 1); PG8_STAGE(PG8_SB(0, 0), b2, voffB);
            PG8_BAR; PG8_WAIT_L(0); PG8_MMA(0, 1, At, B1); PG8_BAR;
            PG8_LDA(At, 0, 1); PG8_STAGE(PG8_SA(0, 0), a2, voffA);
            PG8_BAR; PG8_WAIT_L(0); PG8_MMA(1, 0, At, B0); PG8_BAR; PG8_SCHED;
            PG8_STAGE(PG8_SB(0, 1), b2 + hstep, voffB);
            PG8_WAIT_V(6); PG8_BAR; PG8_MMA(1, 1, At, B1); PG8_BAR;
            PG8_LDB(B0, 1, 0); PG8_SCHED; PG8_LDA(At, 1, 0); PG8_STAGE(PG8_SA(0, 1), a2 + hstep, voffA);
            PG8_WAIT_L(8); PG8_BAR; PG8_WAIT_L(0); PG8_MMA(0, 0, At, B0); PG8_BAR; PG8_SCHED;
            PG8_LDB(B1, 1, 1); PG8_STAGE(PG8_SB(1, 0), b3, voffB);
            PG8_BAR; PG8_WAIT_L(0); PG8_MMA(0, 1, At, B1); PG8_BAR;
            PG8_LDA(At, 1, 1); PG8_STAGE(PG8_SA(1, 0), a3, voffA);
            PG8_BAR; PG8_WAIT_L(0); PG8_MMA(1, 0, At, B0); PG8_BAR; PG8_SCHED;
            PG8_STAGE(PG8_SB(1, 1), b3 + hstep, voffB);
            PG8_WAIT_V(6); PG8_BAR; PG8_MMA(1, 1, At, B1); PG8_BAR;
            }
        }
        if constexpr (ALIGN_EPI) { if (wr == 0) PG8_BAR; }
        if constexpr (!Epi::AFTER_DRAIN) { E(acc, cur, wr, wc, fr, fq); S.done(cur); }
        if (!has_next) break;
#pragma unroll
        for (int a = 0; a < 2; ++a)
#pragma unroll
            for (int b = 0; b < 2; ++b)
#pragma unroll
                for (int m = 0; m < 4; ++m)
#pragma unroll
                    for (int n = 0; n < 2; ++n) acc[a][b][m][n] = (f32x4){0.f, 0.f, 0.f, 0.f};
        cur = nxt; cA = nA; cB = nB; ++ui;
        if constexpr (ALIGN_EPI) { if (wr == 1) PG8_BAR; }
    }
    PG8_WAIT_V(0);
    if constexpr (!ALIGN_EPI) { if (wr == 0) PG8_BAR; }
    PG8_BAR;
    if constexpr (Epi::AFTER_DRAIN) { E.fused(acc, cur, wr, wc, fr, fq, lds, wid, lane); S.done(cur); }
#undef PG8_SA
#undef PG8_SB
#undef PG8_STAGE
#undef PG8_LDA
#undef PG8_LDB
#undef PG8_MMA
#undef PG8_WAIT_V
#undef PG8_WAIT_L
#undef PG8_BAR
#undef PG8_SCHED
}
}

#define GAS __attribute__((address_space(1)))
#define LAS __attribute__((address_space(3)))
typedef unsigned short bf16;
typedef unsigned v4u __attribute__((ext_vector_type(4)));
typedef float f32x4 __attribute__((ext_vector_type(4)));
typedef short bf16x8 __attribute__((ext_vector_type(8)));
typedef GAS unsigned gu32;
typedef GAS unsigned long long gu64;
#define RLX_AGENT __ATOMIC_RELAXED, __HIP_MEMORY_SCOPE_AGENT
#define LDS_WAIT() asm volatile("s_waitcnt lgkmcnt(0)" ::: "memory")
#define VM_WAIT() asm volatile("s_waitcnt vmcnt(0)" ::: "memory")
__device__ __forceinline__ unsigned long long rt() { return __builtin_amdgcn_s_memrealtime(); }
__device__ __forceinline__ unsigned f2bf(float f) { unsigned u = __builtin_bit_cast(unsigned, f); return (u + 0x7fffu + ((u >> 16) & 1u)) >> 16; }
__device__ __forceinline__ unsigned pk2(float lo, float hi) { return f2bf(lo) | (f2bf(hi) << 16); }

#define XB_TMO      128
#define XB_XCNT(j)  (256  + 64 * (j))
#define XB_XSUB(j)  (1280 + 64 * (j))
#define XB_XGEN(j)  (2304 + 64 * (j))
#define XB_TOP      3328
#define XB_TOPGEN   3392
#define XCD_BAR_WORDS 3456
#define XB_SPIN_CAP (1u << 18)

__device__ __forceinline__ unsigned xb_ld(unsigned* p)              { return __hip_atomic_load(p, __ATOMIC_RELAXED, __HIP_MEMORY_SCOPE_AGENT); }
__device__ __forceinline__ unsigned xb_add(unsigned* p, unsigned v) { return __hip_atomic_fetch_add(p, v, __ATOMIC_RELAXED, __HIP_MEMORY_SCOPE_AGENT); }
__device__ __forceinline__ unsigned xb_xcc_id() { return (unsigned)__builtin_amdgcn_s_getreg((3 << 11) | 20) & 0xFu; }
#define XB_SPIN(cond, bar) do { unsigned _sp = 0; while (cond) { __builtin_amdgcn_s_sleep(1); \
    if ((++_sp & 255u) == 0u) { if (xb_ld(&(bar)[XB_TMO])) break; if (_sp > XB_SPIN_CAP) { atomicAdd(&(bar)[XB_TMO], 1u); break; } } } } while (0)

struct XcdBarrier {
    unsigned* bar; unsigned x;
    volatile LAS unsigned* st;
};

__device__ __forceinline__ XcdBarrier xcd_barrier_post(unsigned* bar, volatile LAS unsigned* st) {
    XcdBarrier b; b.bar = bar; b.x = xb_xcc_id(); b.st = st;
    if (threadIdx.x == 0) (void)xb_add(&bar[XB_XCNT(b.x)], 1u);
    return b;
}
__device__ __forceinline__ void xcd_barrier_complete(unsigned* bar, unsigned x, unsigned& nloc, unsigned& nx) {
    const unsigned G = gridDim.x * gridDim.y * gridDim.z;
    unsigned sum, cnt, mine, sp = 0u;
    for (;;) {
        sum = 0u; cnt = 0u; mine = 0u;
#pragma unroll
        for (unsigned j = 0; j < 16; ++j) { const unsigned c = xb_ld(&bar[XB_XCNT(j)]); sum += c; cnt += (c > 0u) ? 1u : 0u; mine = (j == x) ? c : mine; }
        if (sum == G) break;
        __builtin_amdgcn_s_sleep(1);
        if ((++sp & 255u) == 0u) { if (xb_ld(&bar[XB_TMO])) break; if (sp > XB_SPIN_CAP) { atomicAdd(&bar[XB_TMO], 1u); break; } }
    }
    nloc = mine > 0u ? mine : 1u; nx = cnt > 0u ? cnt : 1u;
}

__device__ __forceinline__ void xcd_barrier(const XcdBarrier& b) {
    asm volatile("s_waitcnt vmcnt(0)" ::: "memory");
    __syncthreads();
    if (threadIdx.x == 0) {
        unsigned* bar = b.bar;
        __builtin_amdgcn_s_waitcnt(0);
        unsigned nloc = b.st[0], nx = b.st[1];
        if (nloc == 0u) { xcd_barrier_complete(bar, b.x, nloc, nx); b.st[0] = nloc; b.st[1] = nx; }
        const unsigned old = xb_add(&bar[XB_XSUB(b.x)], 1u);
        const unsigned gen = old / nloc;
        if (old + 1u == (gen + 1u) * nloc) {
            __builtin_amdgcn_fence(__ATOMIC_RELEASE, "agent");
            asm volatile("s_waitcnt vmcnt(0)" ::: "memory");
            const unsigned og = xb_add(&bar[XB_TOP], 1u);
            const unsigned tg = og / nx;
            if (og + 1u == (tg + 1u) * nx) xb_add(&bar[XB_TOPGEN], 1u);
            else XB_SPIN(xb_ld(&bar[XB_TOPGEN]) == tg, bar);
            __builtin_amdgcn_fence(__ATOMIC_ACQUIRE, "agent");
            xb_add(&bar[XB_XGEN(b.x)], 1u);
            asm volatile("s_waitcnt vmcnt(0)" ::: "memory");
        } else {
            XB_SPIN(xb_ld(&bar[XB_XGEN(b.x)]) == gen, bar);
            __builtin_amdgcn_fence(__ATOMIC_ACQUIRE, "agent");
            asm volatile("s_waitcnt vmcnt(0)" ::: "memory");
        }
    }
    __syncthreads();
}

constexpr int NWAVES = 8;
constexpr int BATCH = 16, SEQ = 2048, D = 1024, M = BATCH * SEQ;
constexpr int SG = 64, SGS = 16, SP = 64;
constexpr int FFD = 2816, FF2 = 5632, AW = 3072, NH = 16, HD = 64, KVQW = 9216;
constexpr int MH = M / 2;
constexpr float DN_ALPHA = 1.4142135623730951f, LN_EPS = 1e-5f;
constexpr float QSCALE = 0.125f;

constexpr size_t MiB = 1u << 20;
constexpr size_t WS_CTL = 0, CTL_ZERO_BYTES = 1 * MiB;
constexpr size_t WS_WGLU = 2 * MiB, WS_WOUT = 4 * MiB, WS_WUP0 = 6 * MiB, WS_WUP1 = 17 * MiB, WS_WDN0 = 28 * MiB, WS_WDN1 = 34 * MiB, WS_WKVQ = 40 * MiB, WS_WAO = 58 * MiB;
constexpr size_t WS_H16 = 64 * MiB, WS_Y16 = 128 * MiB, WS_BIG = 192 * MiB, WS_G16 = 368 * MiB, WS_HS = 432 * MiB, WS_RAW = 480 * MiB, WS_S5T = 492 * MiB, WS_END = 512 * MiB;
static_assert(WS_WUP0 + (size_t)FF2 * D * 2 <= WS_WUP1 && WS_WDN0 + (size_t)D * FFD * 2 <= WS_WDN1 && WS_WDN1 + (size_t)D * FFD * 2 <= WS_WKVQ && WS_WKVQ + (size_t)KVQW * D * 2 <= WS_WAO && WS_WAO + 2 * MiB <= WS_H16, "weights map");
static_assert(WS_BIG + (size_t)MH * KVQW * 2 <= WS_RAW && WS_BIG + (size_t)M * FFD * 2 <= WS_G16 && WS_RAW + (size_t)128 * 4 * FF2 * 4 <= WS_S5T, "activation map");
constexpr int CW_BAR = 4096;
constexpr int MAX_LAUNCHES = 8;

constexpr int RING_OFF = 0, RING_BYTES = 131072;
constexpr int XCH_OFF = RING_BYTES, XCH_BYTES = 8192;
constexpr int LDSCTL_OFF = XCH_OFF + XCH_BYTES, MISC_OFF = LDSCTL_OFF + 320;
constexpr int LDS_BYTES = 147456;
static_assert(MISC_OFF + 128 <= LDS_BYTES, "LDS map");

__device__ const unsigned char BUCKET[3][129] = {
{0,1,2,3,4,5,6,7,8,9,10,11,12,13,14,15,16,16,16,16,16,16,17,17,17,17,17,17,17,17,18,18,18,18,18,18,18,18,18,18,19,19,19,19,19,19,19,19,19,19,19,19,19,19,20,20,20,20,20,20,20,20,20,20,20,20,20,20,20,20,20,20,20,21,21,21,21,21,21,21,21,21,21,21,21,21,21,21,21,21,21,21,21,21,21,21,21,21,21,22,22,22,22,22,22,22,22,22,22,22,22,22,22,22,22,22,22,22,22,22,22,22,22,22,22,22,22,22,22},
{0,4,8,12,16,16,17,17,18,18,19,19,19,19,20,20,20,20,20,21,21,21,21,21,21,22,22,22,22,22,22,22,22,22,23,23,23,23,23,23,23,23,23,23,23,23,24,24,24,24,24,24,24,24,24,24,24,24,24,24,24,24,25,25,25,25,25,25,25,25,25,25,25,25,25,25,25,25,25,25,25,25,25,26,26,26,26,26,26,26,26,26,26,26,26,26,26,26,26,26,26,26,26,26,26,26,26,26,26,26,26,26,26,27,27,27,27,27,27,27,27,27,27,27,27,27,27,27,27},
{0,16,18,19,20,21,21,22,22,23,23,23,24,24,24,24,25,25,25,25,25,26,26,26,26,26,26,26,26,27,27,27,27,27,27,27,27,27,27,28,28,28,28,28,28,28,28,28,28,28,28,28,29,29,29,29,29,29,29,29,29,29,29,29,29,29,29,29,29,29,30,30,30,30,30,30,30,30,30,30,30,30,30,30,30,30,30,30,30,30,30,30,30,30,30,31,31,31,31,31,31,31,31,31,31,31,31,31,31,31,31,31,31,31,31,31,31,31,31,31,31,31,31,31,31,31,31,31,31}};

__device__ __forceinline__ double d_exp_small(double x) {
    double y = x * 0.125, t = 1.0, s = 1.0;
#pragma unroll
    for (int i = 1; i <= 14; ++i) { t *= y / (double)i; s += t; }
    s *= s; s *= s; s *= s; return s;
}
__device__ __forceinline__ void d_sincos(double x, double& sn, double& cs) {
    const double TWO_PI = 6.283185307179586476925286766559;
    const double k = __builtin_rint(x / TWO_PI); const double r = x - k * TWO_PI;
    const double q = r * 0.25, q2 = q * q;
    double s = 0.0, c = 0.0, ts = q, tc = 1.0;
#pragma unroll
    for (int i = 0; i < 10; ++i) { s += ts; c += tc; ts *= -q2 / (double)((2 * i + 2) * (2 * i + 3)); tc *= -q2 / (double)((2 * i + 1) * (2 * i + 2)); }
#pragma unroll
    for (int i = 0; i < 2; ++i) { const double s2 = 2.0 * s * c, c2 = c * c - s * s; s = s2; c = c2; }
    sn = s; cs = c;
}
__device__ __forceinline__ float gelu_tanh(float v) { const float z2 = 1.5957691216057308f * (v + 0.044715f * v * v * v); return v * __builtin_amdgcn_rcpf(1.0f + __expf(-z2)); }
__device__ __forceinline__ float wave_sum(float v) {
#pragma unroll
    for (int o = 1; o < 64; o <<= 1) v += __shfl_xor(v, o);
    return v;
}

struct Ptrs {
    const float* in[22]; float* out; unsigned char* ws;
};
__device__ __forceinline__ void p0_transpose_item(const float* W, int K, int N, bf16* WT, int drow0, LAS float* scr, int kb, int nb, int lane) {
    const int k0 = 64 * kb, n0 = 32 * nb;
#pragma unroll 8
    for (int i = 0; i < 32; ++i) { const int kk = 2 * i + (lane >> 5); scr[kk * 33 + (lane & 31)] = W[(size_t)(k0 + kk) * N + n0 + (lane & 31)]; }
    LDS_WAIT(); asm volatile("" ::: "memory");
    const int c = lane & 7;
#pragma unroll
    for (int j = 0; j < 4; ++j) { const int n = (lane >> 3) + 8 * j; const LAS float* s = scr + (8 * c) * 33 + n;
        v4u o; o.x = pk2(s[0 * 33], s[1 * 33]); o.y = pk2(s[2 * 33], s[3 * 33]); o.z = pk2(s[4 * 33], s[5 * 33]); o.w = pk2(s[6 * 33], s[7 * 33]);
        *(GAS v4u*)(WT + (size_t)(drow0 + n) * K + k0 + 8 * c) = o; }
    LDS_WAIT(); asm volatile("" ::: "memory");
}
template <bool UPMAP> __device__ __forceinline__ bool p0_matrix(int& it, const float* W, int K, int N, bf16* WT, int drow_off, LAS float* scr, int lane) {
    const int nblk = N / 32, items = (K / 64) * nblk;
    if (it >= items) { it -= items; return false; }
    const int kb = it / nblk, nb = it % nblk; int drow0 = drow_off + 32 * nb;
    if (UPMAP) { const int n0 = 32 * nb, hh = n0 / FFD, cc = n0 % FFD; drow0 = 256 * (cc / 128) + 128 * hh + (cc % 128); }
    p0_transpose_item(W, K, N, WT, drow0, scr, kb, nb, lane); return true;
}
__device__ __forceinline__ void p0_prologue(const Ptrs& P, LAS unsigned char* lds, int gw, int NGW, int wave, int lane) {
    LAS float* scr = (LAS float*)(lds + RING_OFF + wave * 16384);
    unsigned char* ws = P.ws;
    constexpr int I_DD = 16 * 32, I_UP = 16 * 176, I_DN = 44 * 32, I_KV = 16 * 192, I_Q = 16 * 96;
    constexpr int NITEMS = 3 * I_DD + 2 * I_UP + 2 * I_DN + I_KV + I_Q;
    for (int it0 = gw; it0 < NITEMS; it0 += NGW) {
        int it = it0;
        if (p0_matrix<false>(it, P.in[9], D, D, (bf16*)(ws + WS_WGLU), 0, scr, lane)) continue;
        if (p0_matrix<false>(it, P.in[11], D, D, (bf16*)(ws + WS_WOUT), 0, scr, lane)) continue;
        if (p0_matrix<true>(it, P.in[16], D, FF2, (bf16*)(ws + WS_WUP0), 0, scr, lane)) continue;
        if (p0_matrix<true>(it, P.in[16] + (size_t)D * FF2, D, FF2, (bf16*)(ws + WS_WUP1), 0, scr, lane)) continue;
        if (p0_matrix<false>(it, P.in[19], FFD, D, (bf16*)(ws + WS_WDN0), 0, scr, lane)) continue;
        if (p0_matrix<false>(it, P.in[19] + (size_t)FFD * D, FFD, D, (bf16*)(ws + WS_WDN1), 0, scr, lane)) continue;
        if (p0_matrix<false>(it, P.in[12], D, 2 * AW, (bf16*)(ws + WS_WKVQ), 0, scr, lane)) continue;
        if (p0_matrix<false>(it, P.in[13], D, AW, (bf16*)(ws + WS_WKVQ), 2 * AW, scr, lane)) continue;
        p0_matrix<false>(it, P.in[14], D, D, (bf16*)(ws + WS_WAO), 0, scr, lane);
    }
}

__device__ __forceinline__ void s5_simple(const Ptrs& P, LAS unsigned char* lds, int vcu, int wave, int lane) {
    if (wave >= 4) return;
    const int unit = vcu * 4 + wave; if (unit >= BATCH * SG) return;
    const int b = unit / SG, g = unit % SG, p = lane;
    const float* x = P.in[0]; bf16* Y = (bf16*)(P.ws + WS_Y16);
    LAS float* hs = (LAS float*)(lds + RING_OFF + wave * 16384);
    LAS float* cr = hs + 128; LAS float* ci = cr + 16 * 65;
    for (int i = p; i < 16 * 64; i += 64) { cr[(i / 64) * 65 + (i % 64)] = P.in[6][g * 1024 + i]; ci[(i / 64) * 65 + (i % 64)] = P.in[7][g * 1024 + i]; }
    const double dth = d_exp_small((double)P.in[3][g] * 0.5), dt = dth * dth;
    const double lr = P.in[1][g * SP + p], li = P.in[2][g * SP + p];
    const double mag = d_exp_small(lr * dt); double sn, cs; d_sincos(li * dt, sn, cs);
    const double abr = mag * cs, abi = mag * sn, den = lr * lr + li * li, nr = abr - 1.0;
    const double cor = (nr * lr + abi * li) / den, coi = (abi * lr - nr * li) / den;
    float bbr[16], bbi[16];
#pragma unroll
    for (int h = 0; h < 16; ++h) { const double br = P.in[4][(g * SP + p) * 16 + h], bi = P.in[5][(g * SP + p) * 16 + h]; bbr[h] = (float)(cor * br - coi * bi); bbi[h] = (float)(cor * bi + coi * br); }
    const float ar = (float)abr, ai = (float)abi;
    const float dsk_l = p < 16 ? P.in[8][g * 16 + p] : 0.f;
    float hr = 0.f, hi = 0.f;
    LDS_WAIT(); asm volatile("" ::: "memory");
    for (int t = 0; t < SEQ; ++t) {
        const float* ur = x + ((size_t)(b * SEQ + t)) * D + g * 16;
        const f32x4 u0 = *(const f32x4*)ur, u1 = *(const f32x4*)(ur + 4), u2 = *(const f32x4*)(ur + 8), u3 = *(const f32x4*)(ur + 12);
        const float u[16] = {u0[0], u0[1], u0[2], u0[3], u1[0], u1[1], u1[2], u1[3], u2[0], u2[1], u2[2], u2[3], u3[0], u3[1], u3[2], u3[3]};
        float sr = 0.f, si = 0.f;
#pragma unroll
        for (int h = 0; h < 16; ++h) { sr += bbr[h] * u[h]; si += bbi[h] * u[h]; }
        const float nhr = ar * hr - ai * hi + sr, nhi = ar * hi + ai * hr + si;
        hr = nhr; hi = nhi;
        hs[p] = hr; hs[64 + p] = hi;
        LDS_WAIT(); asm volatile("" ::: "memory");
        if (p < 16) {
            float y = 0.f;
#pragma unroll 8
            for (int q = 0; q < 64; ++q) y += cr[p * 65 + q] * hs[q] - ci[p * 65 + q] * hs[64 + q];
            y += dsk_l * ur[p];
            Y[((size_t)(b * SEQ + t)) * D + g * 16 + p] = (bf16)f2bf(gelu_tanh(y));
        }
        LDS_WAIT(); asm volatile("" ::: "memory");
    }
}

__device__ __forceinline__ void ln_phase(float* Z, const float* gain, const float* bias, bf16* H16, int gw, int NGW, int lane) {
    f32x4 gv[4], bv[4];
#pragma unroll
    for (int j = 0; j < 4; ++j) { gv[j] = *(const f32x4*)(gain + 4 * lane + 256 * j); bv[j] = *(const f32x4*)(bias + 4 * lane + 256 * j); }
    for (int m = gw; m < M; m += NGW) {
        GAS f32x4* zr = (GAS f32x4*)(Z + (size_t)m * D) + lane;
        f32x4 v[4]; float s = 0.f;
#pragma unroll
        for (int j = 0; j < 4; ++j) { v[j] = zr[64 * j]; s += (v[j].x + v[j].y) + (v[j].z + v[j].w); }
        const float mean = wave_sum(s) * (1.f / D); float s2 = 0.f;
#pragma unroll
        for (int j = 0; j < 4; ++j) { v[j] = v[j] - mean; s2 += (v[j].x * v[j].x + v[j].y * v[j].y) + (v[j].z * v[j].z + v[j].w * v[j].w); }
        const float rstd = 1.f / sqrtf(wave_sum(s2) * (1.f / D) + LN_EPS);
#pragma unroll
        for (int j = 0; j < 4; ++j) { v[j] = v[j] * rstd * gv[j] + bv[j]; zr[64 * j] = v[j]; }
        if (H16) { GAS unsigned long long* o8 = (GAS unsigned long long*)(H16 + (size_t)m * D) + lane;
#pragma unroll
            for (int j = 0; j < 4; ++j) o8[64 * j] = (unsigned long long)pk2(v[j].x, v[j].y) | ((unsigned long long)pk2(v[j].z, v[j].w) << 32); }
    }
}

__device__ __forceinline__ void fixup_phase(const float* RAW, const float* cw, const float* cb, bf16* ACT, int gt, int NGT) {
    for (int i = gt; i < 128 * 2 * FFD; i += NGT) {
        const int pm = i / (2 * FFD), j = (i / FFD) & 1, c = i % FFD;
        if ((pm & 7) == 0) continue;
        const int nv = 256 * (c / 128) + (c % 128), ng = nv + 128;
        const float* r0 = RAW + (size_t)(pm * 4) * FF2; const float* rp = RAW + (size_t)((pm - 1) * 4) * FF2;
        float val, gate;
        if (j == 0) { val = cb[c] + cw[c] * r0[nv] + cw[FF2 + c] * rp[3 * FF2 + nv] + cw[2 * FF2 + c] * rp[2 * FF2 + nv];
                      gate = cb[FFD + c] + cw[FFD + c] * r0[ng] + cw[FF2 + FFD + c] * rp[3 * FF2 + ng] + cw[2 * FF2 + FFD + c] * rp[2 * FF2 + ng]; }
        else { val = cb[c] + cw[c] * r0[FF2 + nv] + cw[FF2 + c] * r0[nv] + cw[2 * FF2 + c] * rp[3 * FF2 + nv];
               gate = cb[FFD + c] + cw[FFD + c] * r0[FF2 + ng] + cw[FF2 + FFD + c] * r0[ng] + cw[2 * FF2 + FFD + c] * rp[3 * FF2 + ng]; }
        ACT[(size_t)(pm * 256 + j) * FFD + c] = (bf16)f2bf(gate * __builtin_amdgcn_rcpf(1.0f + __expf(-gate)) * val);
    }
}

__device__ __forceinline__ void attn_simple(const bf16* KVQ, const float* rel_bias, bf16* O16, int half, int gt, int NGT) {
    for (int idx = gt; idx < MH * NH; idx += NGT) {
        const int h = idx / MH, r = idx % MH, t = r % SEQ;
        float o[64]; float mx = -1e30f, l = 0.f;
#pragma unroll
        for (int e = 0; e < 64; ++e) o[e] = 0.f;
        for (int g = 0; g < 3; ++g) {
            const int dil = g == 0 ? 1 : (g == 1 ? 4 : 16);
            float q[64];
            { const v4u* qp = (const v4u*)(KVQ + (size_t)r * KVQW + 2 * AW + g * 1024 + h * 64);
#pragma unroll
              for (int i = 0; i < 8; ++i) { const v4u w = qp[i]; q[8 * i] = __uint_as_float(w.x << 16); q[8 * i + 1] = __uint_as_float(w.x & 0xffff0000u); q[8 * i + 2] = __uint_as_float(w.y << 16); q[8 * i + 3] = __uint_as_float(w.y & 0xffff0000u);
                  q[8 * i + 4] = __uint_as_float(w.z << 16); q[8 * i + 5] = __uint_as_float(w.z & 0xffff0000u); q[8 * i + 6] = __uint_as_float(w.w << 16); q[8 * i + 7] = __uint_as_float(w.w & 0xffff0000u); } }
            for (int s = 0; s <= 128; ++s) {
                if (t - s * dil < 0) break;
                const v4u* kp = (const v4u*)(KVQ + (size_t)(r - s * dil) * KVQW + g * 1024 + h * 64); const v4u* vp = kp + AW / 8;
                float sc = 0.f;
#pragma unroll
                for (int i = 0; i < 8; ++i) { const v4u w = kp[i];
                    sc += q[8 * i] * __uint_as_float(w.x << 16) + q[8 * i + 1] * __uint_as_float(w.x & 0xffff0000u) + q[8 * i + 2] * __uint_as_float(w.y << 16) + q[8 * i + 3] * __uint_as_float(w.y & 0xffff0000u)
                        + q[8 * i + 4] * __uint_as_float(w.z << 16) + q[8 * i + 5] * __uint_as_float(w.z & 0xffff0000u) + q[8 * i + 6] * __uint_as_float(w.w << 16) + q[8 * i + 7] * __uint_as_float(w.w & 0xffff0000u); }
                sc += rel_bias[BUCKET[g][s] * 48 + g * 16 + h];
                if (sc > mx) { const float f = __expf(mx - sc); l *= f;
#pragma unroll
                    for (int e = 0; e < 64; ++e) o[e] *= f;
                    mx = sc; }
                const float pe = __expf(sc - mx); l += pe;
#pragma unroll
                for (int i = 0; i < 8; ++i) { const v4u w = vp[i];
                    o[8 * i] += pe * __uint_as_float(w.x << 16); o[8 * i + 1] += pe * __uint_as_float(w.x & 0xffff0000u); o[8 * i + 2] += pe * __uint_as_float(w.y << 16); o[8 * i + 3] += pe * __uint_as_float(w.y & 0xffff0000u);
                    o[8 * i + 4] += pe * __uint_as_float(w.z << 16); o[8 * i + 5] += pe * __uint_as_float(w.z & 0xffff0000u); o[8 * i + 6] += pe * __uint_as_float(w.w << 16); o[8 * i + 7] += pe * __uint_as_float(w.w & 0xffff0000u); }
            }
        }
        const float inv = 1.0f / l; v4u* op = (v4u*)(O16 + (size_t)(half * MH + r) * D + h * 64);
#pragma unroll
        for (int i = 0; i < 8; ++i) { v4u w; w.x = pk2(o[8 * i] * inv, o[8 * i + 1] * inv); w.y = pk2(o[8 * i + 2] * inv, o[8 * i + 3] * inv); w.z = pk2(o[8 * i + 4] * inv, o[8 * i + 5] * inv); w.w = pk2(o[8 * i + 6] * inv, o[8 * i + 7] * inv); op[i] = w; }
    }
}

struct Args { const float* in[22]; float* out; unsigned char* ws; int ph_lo, ph_hi, li, pad; };
constexpr int N_PHASES = 19;
__global__ void __launch_bounds__(NWAVES * 64, 2) mk_fwd(Args args) {
    extern __shared__ __attribute__((aligned(16))) unsigned char lds_raw[];
    LAS unsigned char* lds = (LAS unsigned char*)lds_raw;
    volatile LAS unsigned* MISC = (volatile LAS unsigned*)(lds + MISC_OFF);
    const int G = gridDim.x, bx = blockIdx.x, vcu = (G % 8 == 0) ? (bx % 8) * (G / 8) + bx / 8 : bx;
    Ptrs P;
#pragma unroll
    for (int i = 0; i < 22; ++i) P.in[i] = args.in[i];
    P.out = args.out; P.ws = args.ws;
    unsigned char* ws = args.ws;
    gu32* ctl = (gu32*)(ws + WS_CTL);
    for (int u = threadIdx.x; u < (LDS_BYTES - LDSCTL_OFF) / 4; u += NWAVES * 64) ((LAS unsigned*)(lds + LDSCTL_OFF))[u] = 0u;
    __syncthreads();
    XcdBarrier bar = xcd_barrier_post((unsigned*)(ctl + CW_BAR) + args.li * XCD_BAR_WORDS, MISC + 8);
    bf16* H16 = (bf16*)(ws + WS_H16); bf16* Y16 = (bf16*)(ws + WS_Y16); bf16* G16 = (bf16*)(ws + WS_G16); bf16* ACT = (bf16*)(ws + WS_BIG); bf16* KVQ = (bf16*)(ws + WS_BIG);
    float* RAW = (float*)(ws + WS_RAW); float* out = args.out;
    const float* ln_g = args.in[20]; const float* ln_b = args.in[21];

    for (int ph = args.ph_lo; ph < args.ph_hi; ++ph) {
        int tid = threadIdx.x; asm volatile("" : "+v"(tid));
        const int lane = tid & 63, wave = __builtin_amdgcn_readfirstlane(tid >> 6);
        const int gw = vcu * NWAVES + wave, NGW = G * NWAVES, gt = vcu * (NWAVES * 64) + tid, NGT = G * NWAVES * 64;
        if (ph == 0) p0_prologue(P, lds, gw, NGW, wave, lane);
        else if (ph == 1) {
#ifndef SKIP_S5
            s5_simple(P, lds, vcu, wave, lane);
#endif
        }
        else if (ph == 2) {
            pg8::Gemm g{Y16, (const bf16*)(ws + WS_WGLU), M, D, D}; pg8::StaticOrder S; S.init(M, D, G, bx);
            pg8::EpiGlu E{Y16, args.in[10], G16, D};
#ifndef SKIP_GLU
            pg8::gemm_phase<pg8::EpiGlu, pg8::StaticOrder, true, true>(lds + RING_OFF, g, S, E, tid);
#endif
        } else if (ph == 3 || ph == 7 || ph == 13 || ph == 17) {
            const bf16* A = ph == 3 ? G16 : (ph == 13 ? Y16 : ACT);
            const bf16* Bt = (const bf16*)(ws + (ph == 3 ? WS_WOUT : ph == 7 ? WS_WDN0 : ph == 13 ? WS_WAO : WS_WDN1));
            const int K = (ph == 7 || ph == 17) ? FFD : D;
            pg8::Gemm g{A, Bt, M, D, K}; pg8::StaticOrder S; S.init(M, D, G, bx);
            pg8::EpiRes E{ph == 3 ? args.in[0] : out, out, D, DN_ALPHA};
#ifndef SKIP_RES
            pg8::gemm_phase<pg8::EpiRes, pg8::StaticOrder, true, true>(lds + RING_OFF, g, S, E, tid);
#endif
        } else if (ph == 4 || ph == 8 || ph == 14 || ph == 18) {
            const int li = ph == 4 ? 0 : ph == 8 ? 1 : ph == 14 ? 2 : 3;
            ln_phase(out, ln_g + li * D, ln_b + li * D, ph == 18 ? (bf16*)nullptr : H16, gw, NGW, lane);
        } else if (ph == 5 || ph == 15) {
            const int layer = ph == 5 ? 0 : 1;
            pg8::Gemm g{H16, (const bf16*)(ws + (layer ? WS_WUP1 : WS_WUP0)), M, FF2, D}; pg8::StaticOrder S; S.init(M, FF2, G, bx);
            pg8::EpiConvGate E{ACT, args.in[17] + (size_t)layer * 3 * FF2, args.in[18] + (size_t)layer * FF2, RAW, (PG8_LAS float*)(lds + XCH_OFF)};
#ifndef SKIP_UP
            pg8::gemm_phase<pg8::EpiConvGate, pg8::StaticOrder, true, true>(lds + RING_OFF, g, S, E, tid);
#endif
        } else if (ph == 6 || ph == 16) {
            const int layer = ph == 6 ? 0 : 1;
            fixup_phase(RAW, args.in[17] + (size_t)layer * 3 * FF2, args.in[18] + (size_t)layer * FF2, ACT, gt, NGT);
        } else if (ph == 9 || ph == 11) {
            const int half = ph == 9 ? 0 : 1;
            pg8::Gemm g{H16 + (size_t)half * MH * D, (const bf16*)(ws + WS_WKVQ), MH, KVQW, D}; pg8::StaticOrder S; S.init(MH, KVQW, G, bx);
            pg8::EpiKVQ E{KVQ, KVQW, 2 * AW, QSCALE};
#ifndef SKIP_KVQ
            pg8::gemm_phase<pg8::EpiKVQ, pg8::StaticOrder, true, true>(lds + RING_OFF, g, S, E, tid);
#endif
        } else if (ph == 10 || ph == 12) {
#ifndef SKIP_ATT
            attn_simple(KVQ, args.in[15], Y16, ph == 10 ? 0 : 1, gt, NGT);
#endif
        }
        if (ph + 1 < args.ph_hi) xcd_barrier(bar);
    }
}

extern "C" void kernel_launch(void* const* d_in, const int* in_sizes, int n_in, void* d_out, int out_size, void* d_ws, size_t ws_size, hipStream_t stream) {
    static int grid = 0;
    if (grid == 0) {
        if (n_in != 22 || in_sizes[0] != M * D || out_size != M * D || ws_size < WS_END) { fprintf(stderr, "kernel_launch: unexpected shapes / workspace (%d inputs, ws %zu)\n", n_in, ws_size); grid = -1; return; }
        int dev = 0, cus = 0, per_cu = 0;
        if (hipGetDevice(&dev) != hipSuccess || hipDeviceGetAttribute(&cus, hipDeviceAttributeMultiprocessorCount, dev) != hipSuccess) { grid = -1; return; }
        if (hipFuncSetAttribute((const void*)mk_fwd, hipFuncAttributeMaxDynamicSharedMemorySize, LDS_BYTES) != hipSuccess) { grid = -1; return; }
        if (hipOccupancyMaxActiveBlocksPerMultiprocessor(&per_cu, (const void*)mk_fwd, NWAVES * 64, LDS_BYTES) != hipSuccess || per_cu < 1) fprintf(stderr, "kernel_launch: occupancy query reports %d\n", per_cu);
        (void)hipGetLastError();
        grid = cus;
        if (grid != 256) fprintf(stderr, "kernel_launch: %d CUs; the unit schedule expects 256\n", grid);
    }
    if (grid < 0) return;
    if (hipMemsetAsync((char*)d_ws + WS_CTL, 0, CTL_ZERO_BYTES, stream) != hipSuccess) return;
    Args a{};
    for (int i = 0; i < 22; ++i) a.in[i] = (const float*)d_in[i];
    a.out = (float*)d_out; a.ws = (unsigned char*)d_ws;
#ifndef MK_CUTS
#define MK_CUTS {0, N_PHASES}
#endif
    const int cuts[] = MK_CUTS; const int nl = (int)(sizeof(cuts) / sizeof(int)) - 1;
    for (int li = 0; li < nl; ++li) {
        a.ph_lo = cuts[li]; a.ph_hi = cuts[li + 1]; a.li = li;
        hipLaunchKernelGGL(mk_fwd, dim3(grid), dim3(NWAVES * 64), LDS_BYTES, stream, a);
    }
}
```

```cpp
#include <hip/hip_runtime.h>
#include <cstdio>
#include <cstdint>
namespace pg8 {
#define PG8_LAS __attribute__((address_space(3)))
typedef unsigned short bf16_t;
typedef short bf16x8 __attribute__((ext_vector_type(8)));
typedef float f32x4 __attribute__((ext_vector_type(4)));
typedef unsigned u32x4 __attribute__((ext_vector_type(4)));
constexpr int BM = 256, BK = 64, HALF = 128, HTB = HALF * BK * 2  , STAGE_BYTES = 8 * HTB, NXCD = 8, WGM = 8;

__host__ __device__ __forceinline__ int lds_byte(int r, int c) { const int st = (r >> 4) * 2 + (c >> 5), rr = r & 15, cc = c & 31, ob = rr * 64 + cc * 2; return st * 1024 + (ob ^ (((ob >> 9) & 1) << 5)); }
__host__ __device__ __forceinline__ void stage_rc(int b, int& R, int& C) { const int st = b / 1024, sb = b % 1024, swz = sb ^ (((sb >> 9) & 1) << 5); R = (st >> 1) * 16 + swz / 64; C = (st & 1) * 32 + (swz % 64) / 2; }
__host__ __device__ __forceinline__ int perm32(int rho) { const int n = rho >> 4, i = rho & 15; return 8 * (i >> 2) + 4 * n + (i & 3); }

struct Unit { int pm, pn; };
struct Gemm { const bf16_t* A; const bf16_t* Bt; int M, N, K; };

struct StaticOrder {
    int nM, nN, nwg, G, c;
    __host__ __device__ void init(int M, int N, int G_, int c_) { nM = M / BM; nN = N / BM; nwg = nM * nN; G = G_; c = c_; }
    __host__ __device__ bool next(int i, Unit& u) const {
        const long L = (long)i * G + c; if (L >= nwg) return false;
        int wgid = (int)L; { const int q = nwg / NXCD, r = nwg % NXCD, xcd = wgid % NXCD, off = wgid / NXCD; wgid = (xcd < r ? xcd * (q + 1) : r * (q + 1) + (xcd - r) * q) + off; }
        const int nig = WGM * nN, gid = wgid / nig, fm = gid * WGM, gsz = (nM - fm) < WGM ? (nM - fm) : WGM;
        u.pm = fm + ((wgid % nig) % gsz); u.pn = (wgid % nig) / gsz; return true;
    }
    __device__ __forceinline__ void a_ready(const Unit&) const {}
    __device__ __forceinline__ void done(const Unit&) const {}
};
__device__ __forceinline__ unsigned cvt_pk_bf16(float lo, float hi) { unsigned r; asm volatile("v_cvt_pk_bf16_f32 %0, %1, %2" : "=v"(r) : "v"(lo), "v"(hi)); return r; }

__device__ __forceinline__ float bf_lo(unsigned u) { return __uint_as_float(u << 16); }
__device__ __forceinline__ float bf_hi(unsigned u) { return __uint_as_float(u & 0xffff0000u); }
__device__ __forceinline__ float fast_sigmoid(float v) { return __builtin_amdgcn_rcpf(1.0f + __expf(-v)); }
template <int CTRL> __device__ __forceinline__ float dpp_mov(float old, float src) {
    return __uint_as_float((unsigned)__builtin_amdgcn_update_dpp((int)__float_as_uint(old), (int)__float_as_uint(src), CTRL, 0xf, 0xf, false));
}
constexpr int DPP_SHR1 = 0x111, DPP_SHR2 = 0x112, DPP_ROR1 = 0x121, DPP_ROR2 = 0x122;

struct EpiGlu {
    static constexpr bool PERM = true, AFTER_DRAIN = false;
    const bf16_t* Y; const float* bias; bf16_t* O; int ldc;
    __device__ __forceinline__ void operator()(const f32x4 (&acc)[2][2][4][2], const Unit& u, int wr, int wc, int fr, int fq) const {
        const int row0 = u.pm * BM + wr * 64 + fr, col0 = u.pn * BM + wc * 32 + 8 * fq;
        f32x4 bv[2][2];
#pragma unroll
        for (int bj = 0; bj < 2; ++bj)
#pragma unroll
            for (int n = 0; n < 2; ++n) bv[bj][n] = *(const f32x4*)(bias + col0 + bj * HALF + 4 * n);
#pragma unroll
        for (int ai = 0; ai < 2; ++ai)
#pragma unroll
            for (int m = 0; m < 4; ++m) { const size_t off = (size_t)(row0 + ai * HALF + m * 16) * ldc + col0;
#pragma unroll
                for (int bj = 0; bj < 2; ++bj) { const u32x4 yv = *(const u32x4*)(Y + off + bj * HALF);
                    const f32x4 v0 = acc[ai][bj][m][0] + bv[bj][0], v1 = acc[ai][bj][m][1] + bv[bj][1];
                    u32x4 w;
                    w.x = cvt_pk_bf16(bf_lo(yv.x) * fast_sigmoid(v0[0]), bf_hi(yv.x) * fast_sigmoid(v0[1]));
                    w.y = cvt_pk_bf16(bf_lo(yv.y) * fast_sigmoid(v0[2]), bf_hi(yv.y) * fast_sigmoid(v0[3]));
                    w.z = cvt_pk_bf16(bf_lo(yv.z) * fast_sigmoid(v1[0]), bf_hi(yv.z) * fast_sigmoid(v1[1]));
                    w.w = cvt_pk_bf16(bf_lo(yv.w) * fast_sigmoid(v1[2]), bf_hi(yv.w) * fast_sigmoid(v1[3]));
                    *(u32x4*)(O + off + bj * HALF) = w; }
                asm volatile("" ::: "memory"); }
    }
};
struct EpiRes {
    static constexpr bool PERM = false, AFTER_DRAIN = false;
    const float* R; float* Z; int ldc; float alpha;
    __device__ __forceinline__ void operator()(const f32x4 (&acc)[2][2][4][2], const Unit& u, int wr, int wc, int fr, int fq) const {
        const int row0 = u.pm * BM + wr * 64 + fr, col0 = u.pn * BM + wc * 32 + 4 * fq;
#pragma unroll
        for (int ai = 0; ai < 2; ++ai)
#pragma unroll
            for (int m = 0; m < 4; ++m) { const size_t off = (size_t)(row0 + ai * HALF + m * 16) * ldc + col0;
                f32x4 r[2][2];
#pragma unroll
                for (int bj = 0; bj < 2; ++bj)
#pragma unroll
                    for (int n = 0; n < 2; ++n) r[bj][n] = *(const f32x4*)(R + off + bj * HALF + n * 16);
#pragma unroll
                for (int bj = 0; bj < 2; ++bj)
#pragma unroll
                    for (int n = 0; n < 2; ++n) *(f32x4*)(Z + off + bj * HALF + n * 16) = r[bj][n] * alpha + acc[ai][bj][m][n];
                asm volatile("" ::: "memory"); }
    }
};
struct EpiKVQ {
    static constexpr bool PERM = true, AFTER_DRAIN = false;
    bf16_t* O; int ldc; int qcol0; float qscale;
    __device__ __forceinline__ void operator()(const f32x4 (&acc)[2][2][4][2], const Unit& u, int wr, int wc, int fr, int fq) const {
        const int row0 = u.pm * BM + wr * 64 + fr, colt = u.pn * BM, col0 = colt + wc * 32 + 8 * fq; const float sc = colt >= qcol0 ? qscale : 1.0f;
#pragma unroll
        for (int ai = 0; ai < 2; ++ai)
#pragma unroll
            for (int m = 0; m < 4; ++m) { bf16_t* rowp = O + (size_t)(row0 + ai * HALF + m * 16) * ldc + col0;
#pragma unroll
                for (int bj = 0; bj < 2; ++bj) { const f32x4 v0 = acc[ai][bj][m][0] * sc, v1 = acc[ai][bj][m][1] * sc; u32x4 w;
                    w.x = cvt_pk_bf16(v0[0], v0[1]); w.y = cvt_pk_bf16(v0[2], v0[3]); w.z = cvt_pk_bf16(v1[0], v1[1]); w.w = cvt_pk_bf16(v1[2], v1[3]);
                    *(u32x4*)(rowp + bj * HALF) = w; } }
    }
};
struct EpiConvGate {
    static constexpr bool PERM = true, AFTER_DRAIN = false;
    static constexpr int FFD = 2816;
    bf16_t* ACT; const float* cw; const float* cb; float* RAW; PG8_LAS float* X;
    __device__ __forceinline__ void operator()(f32x4 (&acc)[2][2][4][2], const Unit& u, int wr, int wc, int fr, int fq) const {
        const int cl0 = wc * 32 + 8 * fq;
        const int ncol = u.pn * BM + cl0;
        const int cv = u.pn * HALF + cl0;
        if (fr >= 14) {
#pragma unroll
            for (int ai = 0; ai < 2; ++ai) { PG8_LAS float* xp = X + ((((ai * 2 + wr) * 4 + wc) * 2 + (fr - 14)) * 4 + fq) * 16;
#pragma unroll
                for (int bj = 0; bj < 2; ++bj)
#pragma unroll
                    for (int n = 0; n < 2; ++n) *(PG8_LAS f32x4*)(xp + (bj * 2 + n) * 4) = acc[ai][bj][3][n]; }
        }
        if (wr == 0 && fr < 2) { float* rp = RAW + (size_t)(u.pm * 4 + fr) * (2 * FFD) + ncol;
#pragma unroll
            for (int bj = 0; bj < 2; ++bj)
#pragma unroll
                for (int n = 0; n < 2; ++n) *(f32x4*)(rp + bj * HALF + 4 * n) = acc[0][bj][0][n]; }
        if (wr == 1 && fr >= 14) { float* rp = RAW + (size_t)(u.pm * 4 + 2 + (fr - 14)) * (2 * FFD) + ncol;
#pragma unroll
            for (int bj = 0; bj < 2; ++bj)
#pragma unroll
                for (int n = 0; n < 2; ++n) *(f32x4*)(rp + bj * HALF + 4 * n) = acc[1][bj][3][n]; }
        asm volatile("s_waitcnt lgkmcnt(0)" ::: "memory"); __builtin_amdgcn_s_barrier(); asm volatile("" ::: "memory");
        const bool skip01 = (u.pm & 7) != 0;
#pragma unroll
        for (int bj = 0; bj < 2; ++bj)
#pragma unroll
            for (int n = 0; n < 2; ++n) {
                const f32x4 bsv = *(const f32x4*)(cb + bj * FFD + cv + 4 * n);
                const f32x4 w0 = *(const f32x4*)(cw + bj * FFD + cv + 4 * n), w1 = *(const f32x4*)(cw + (2 * FFD) + bj * FFD + cv + 4 * n), w2 = *(const f32x4*)(cw + 2 * (2 * FFD) + bj * FFD + cv + 4 * n);
#pragma unroll
                for (int ai = 0; ai < 2; ++ai) {
                    const int bi = ai * 2 + wr;
                    f32x4 vb = (f32x4){0.f, 0.f, 0.f, 0.f};
                    if (bi != 0) vb = *(const PG8_LAS f32x4*)(X + (((((bi - 1) * 4 + wc) * 2 + (fr & 1)) * 4 + fq)) * 16 + (bj * 2 + n) * 4);
#pragma unroll
                    for (int m = 3; m >= 0; --m) { f32x4 o;
#pragma unroll
                        for (int e = 0; e < 4; ++e) { const float cur = acc[ai][bj][m][n][e], prv = (m == 0) ? vb[e] : acc[ai][bj][m == 0 ? 0 : m - 1][n][e];
                            const float p1 = dpp_mov<DPP_SHR1>(dpp_mov<DPP_ROR1>(0.f, prv), cur), p2 = dpp_mov<DPP_SHR2>(dpp_mov<DPP_ROR2>(0.f, prv), cur);
                            o[e] = bsv[e] + w0[e] * cur + w1[e] * p1 + w2[e] * p2; }
                        acc[ai][bj][m][n] = o; asm volatile("" : "+v"(acc[ai][bj][m][n])); }
                }
                asm volatile("" ::: "memory");
            }
#pragma unroll
        for (int ai = 0; ai < 2; ++ai)
#pragma unroll
            for (int m = 0; m < 4; ++m) {
                u32x4 pk;
                { const f32x4 v0 = acc[ai][0][m][0], v1 = acc[ai][0][m][1], g0 = acc[ai][1][m][0], g1 = acc[ai][1][m][1];
                  pk.x = cvt_pk_bf16(g0[0] * fast_sigmoid(g0[0]) * v0[0], g0[1] * fast_sigmoid(g0[1]) * v0[1]);
                  pk.y = cvt_pk_bf16(g0[2] * fast_sigmoid(g0[2]) * v0[2], g0[3] * fast_sigmoid(g0[3]) * v0[3]);
                  pk.z = cvt_pk_bf16(g1[0] * fast_sigmoid(g1[0]) * v1[0], g1[1] * fast_sigmoid(g1[1]) * v1[1]);
                  pk.w = cvt_pk_bf16(g1[2] * fast_sigmoid(g1[2]) * v1[2], g1[3] * fast_sigmoid(g1[3]) * v1[3]); }
                const int row = u.pm * BM + ai * HALF + wr * 64 + m * 16 + fr;
                if (!(skip01 && ai == 0 && wr == 0 && m == 0 && fr < 2)) *(u32x4*)(ACT + (size_t)row * FFD + cv) = pk;
            }
        asm volatile("s_waitcnt lgkmcnt(0)" ::: "memory"); __builtin_amdgcn_s_barrier(); asm volatile("" ::: "memory");
    }
};

template <class Epi, class Sched, bool ALIGN_EPI = false, bool SP2 = false>
__device__ __forceinline__ void gemm_phase(PG8_LAS unsigned char* lds, const Gemm g, const Sched& S, const Epi& E, const int tid  ) {
    const int wid = __builtin_amdgcn_readfirstlane(tid >> 6), lane = tid & 63, wr = wid >> 2, wc = wid & 3, fr = lane & 15, fq = lane >> 4;
    const int K = g.K, nt = K / BK;
    unsigned voffA[2], voffB[2];
#pragma unroll
    for (int i = 0; i < 2; ++i) { int R, C; stage_rc(tid * 16 + i * 8192, R, C); const int Rb = Epi::PERM ? ((R & ~31) + perm32(R & 31)) : R;
        voffA[i] = (unsigned)(R * K + C) * 2u; voffB[i] = (unsigned)(Rb * K + C) * 2u; }
    const size_t kstep = (size_t)(BK * 2);
    const size_t hstep = (size_t)HALF * K * 2;
    const size_t tstep = 2 * hstep;
    const unsigned ldsw = (unsigned)wid * 1024u;
    const int aoff = lds_byte(wr * 64 + fr, fq * 8), boff = lds_byte(wc * 32 + fr, fq * 8);
#define PG8_SA(b, h) (((b) * 2 + (h)) * HTB)
#define PG8_SB(b, h) ((4 + (b) * 2 + (h)) * HTB)
#define PG8_STAGE(bufoff, gbase, voff) do { _Pragma("unroll") for (int _i = 0; _i < 2; ++_i) \
        __builtin_amdgcn_global_load_lds((const unsigned*)((const char*)(gbase) + (voff)[_i]), (PG8_LAS unsigned*)(lds + (bufoff) + ldsw + _i * 8192), 16, 0, 0); } while (0)
#define PG8_LDA(dst, b, h) do { _Pragma("unroll") for (int m = 0; m < 4; ++m) _Pragma("unroll") for (int k = 0; k < 2; ++k) dst[m][k] = *(const PG8_LAS bf16x8*)(lds + PG8_SA(b, h) + aoff + m * 2048 + k * 1024); } while (0)
#define PG8_LDB(dst, b, h) do { _Pragma("unroll") for (int n = 0; n < 2; ++n) _Pragma("unroll") for (int k = 0; k < 2; ++k) dst[n][k] = *(const PG8_LAS bf16x8*)(lds + PG8_SB(b, h) + boff + n * 2048 + k * 1024); } while (0)
#define PG8_MMA(ai, bj, At, Bt) do { __builtin_amdgcn_s_setprio(1); _Pragma("unroll") for (int m = 0; m < 4; ++m) _Pragma("unroll") for (int n = 0; n < 2; ++n) _Pragma("unroll") for (int k = 0; k < 2; ++k) \
        acc[ai][bj][m][n] = __builtin_amdgcn_mfma_f32_16x16x32_bf16(Bt[n][k], At[m][k], acc[ai][bj][m][n], 0, 0, 0); __builtin_amdgcn_s_setprio(0); } while (0)
#define PG8_WAIT_V(n) asm volatile("s_waitcnt vmcnt(" #n ")" ::: "memory")
#define PG8_WAIT_L(n) asm volatile("s_waitcnt lgkmcnt(" #n ")" ::: "memory")
#define PG8_BAR __builtin_amdgcn_s_barrier()
#define PG8_SCHED __builtin_amdgcn_sched_barrier(0)
    Unit cur, nxt; int ui = 0;
    if (!S.next(0, cur)) return;
    f32x4 acc[2][2][4][2];
#pragma unroll
    for (int a = 0; a < 2; ++a)
#pragma unroll
        for (int b = 0; b < 2; ++b)
#pragma unroll
            for (int m = 0; m < 4; ++m)
#pragma unroll
                for (int n = 0; n < 2; ++n) acc[a][b][m][n] = (f32x4){0.f, 0.f, 0.f, 0.f};
    bf16x8 At[4][2], B0[2][2], B1[2][2];
    const char* cA = (const char*)g.A + (size_t)cur.pm * tstep; const char* cB = (const char*)g.Bt + (size_t)cur.pn * tstep;
    S.a_ready(cur);
    if constexpr (SP2) {
        PG8_STAGE(PG8_SB(0, 0), cB, voffB); PG8_STAGE(PG8_SB(0, 1), cB + hstep, voffB); PG8_STAGE(PG8_SA(0, 0), cA, voffA); PG8_STAGE(PG8_SA(0, 1), cA + hstep, voffA);
        if (wr == 1) PG8_BAR;
        PG8_WAIT_V(2); PG8_BAR;
        PG8_STAGE(PG8_SB(1, 0), cB + kstep, voffB); PG8_STAGE(PG8_SA(1, 0), cA + kstep, voffA); PG8_STAGE(PG8_SB(1, 1), cB + hstep + kstep, voffB);
        PG8_WAIT_V(6); PG8_BAR;
    } else {
        PG8_STAGE(PG8_SB(0, 0), cB, voffB); PG8_STAGE(PG8_SA(0, 0), cA, voffA); PG8_STAGE(PG8_SB(0, 1), cB + hstep, voffB); PG8_STAGE(PG8_SA(0, 1), cA + hstep, voffA);
        if (wr == 1) PG8_BAR;
        PG8_WAIT_V(4); PG8_BAR;
        PG8_STAGE(PG8_SB(1, 0), cB + kstep, voffB); PG8_STAGE(PG8_SA(1, 0), cA + kstep, voffA); PG8_STAGE(PG8_SB(1, 1), cB + hstep + kstep, voffB);
        PG8_WAIT_V(6); PG8_BAR;
    }
    for (;;) {
        const bool has_next = S.next(ui + 1, nxt);
        const char* nA = has_next ? (const char*)g.A + (size_t)nxt.pm * tstep : cA; const char* nB = has_next ? (const char*)g.Bt + (size_t)nxt.pn * tstep : cB;
        for (int t = 0; t < nt; t += 2) {
            const bool last = (t == nt - 2);
            const char* a1 = cA + (size_t)(t + 1) * kstep;
            const char* a2 = last ? nA : cA + (size_t)(t + 2) * kstep; const char* b2 = last ? nB : cB + (size_t)(t + 2) * kstep;
            const char* a3 = a2 + kstep; const char* b3 = b2 + kstep;
            if (last && has_next) S.a_ready(nxt);
            if constexpr (SP2) {
            PG8_LDB(B0, 0, 0); PG8_LDB(B1, 0, 1); PG8_SCHED; PG8_LDA(At, 0, 0); PG8_STAGE(PG8_SA(1, 1), a1 + hstep, voffA);
            PG8_WAIT_V(8); PG8_WAIT_L(0); PG8_BAR; PG8_MMA(0, 0, At, B0); PG8_MMA(0, 1, At, B1); PG8_BAR; PG8_SCHED;
            PG8_LDA(At, 0, 1); PG8_STAGE(PG8_SB(0, 0), b2, voffB); PG8_STAGE(PG8_SB(0, 1), b2 + hstep, voffB); PG8_STAGE(PG8_SA(0, 0), a2, voffA);
            PG8_WAIT_V(8); PG8_WAIT_L(0); PG8_BAR; PG8_MMA(1, 0, At, B0); PG8_MMA(1, 1, At, B1); PG8_BAR; PG8_SCHED;
            PG8_LDB(B0, 1, 0); PG8_LDB(B1, 1, 1); PG8_SCHED; PG8_LDA(At, 1, 0); PG8_STAGE(PG8_SA(0, 1), a2 + hstep, voffA);
            PG8_WAIT_V(8); PG8_WAIT_L(0); PG8_BAR; PG8_MMA(0, 0, At, B0); PG8_MMA(0, 1, At, B1); PG8_BAR; PG8_SCHED;
            PG8_LDA(At, 1, 1); PG8_STAGE(PG8_SB(1, 0), b3, voffB); PG8_STAGE(PG8_SB(1, 1), b3 + hstep, voffB); PG8_STAGE(PG8_SA(1, 0), a3, voffA);
            PG8_WAIT_V(8); PG8_WAIT_L(0); PG8_BAR; PG8_MMA(1, 0, At, B0); PG8_MMA(1, 1, At, B1); PG8_BAR; PG8_SCHED;
            } else {
            PG8_LDB(B0, 0, 0); PG8_SCHED; PG8_LDA(At, 0, 0); PG8_STAGE(PG8_SA(1, 1), a1 + hstep, voffA);
            PG8_WAIT_L(8); PG8_BAR; PG8_WAIT_L(0); PG8_MMA(0, 0, At, B0); PG8_BAR; PG8_SCHED;
            PG8_LDB(B1, 0, 1); PG8_STAGE(PG8_SB(0, 0), b2, voffB);
            PG8_BAR; PG8_WAIT_L(0); PG8_MMA(0, 1, At, B1); PG8_BAR;
            PG8_LDA(At, 0, 1); PG8_STAGE(PG8_SA(0, 0), a2, voffA);
            PG8_BAR; PG8_WAIT_L(0); PG8_MMA(1, 0, At, B0); PG8_BAR; PG8_SCHED;
            PG8_STAGE(PG8_SB(0, 1), b2 + hstep, voffB);
            PG8_WAIT_V(6); PG8_BAR; PG8_MMA(1, 1, At, B1); PG8_BAR;
            PG8_LDB(B0, 1, 0); PG8_SCHED; PG8_LDA(At, 1, 0); PG8_STAGE(PG8_SA(0, 1), a2 + hstep, voffA);
            PG8_WAIT_L(8); PG8_BAR; PG8_WAIT_L(0); PG8_MMA(0, 0, At, B0); PG8_BAR; PG8_SCHED;
            PG8_LDB(B1, 1, 1); PG8_STAGE(PG8_SB(1, 0), b3, voffB);
            PG8_BAR; PG8_WAIT_L(0); PG8_MMA(0, 1, At, B1); PG8_BAR;
            PG8_LDA(At, 1, 1); PG8_STAGE(PG8_SA(1, 0), a3, voffA);
            PG8_BAR; PG8_WAIT_L(0); PG8_MMA(1, 0, At, B0); PG8_BAR; PG8_SCHED;
            PG8_STAGE(PG8_SB(1, 1), b3 + hstep, voffB);
            PG8_WAIT_V(6); PG8_BAR; PG8_MMA(1, 1, At, B1); PG8_BAR;
            }
        }
        if constexpr (ALIGN_EPI) { if (wr == 0) PG8_BAR; }
        if constexpr (!Epi::AFTER_DRAIN) { E(acc, cur, wr, wc, fr, fq); S.done(cur); }
        if (!has_next) break;
#pragma unroll
        for (int a = 0; a < 2; ++a)
#pragma unroll
            for (int b = 0; b < 2; ++b)
#pragma unroll
                for (int m = 0; m < 4; ++m)
#pragma unroll
                    for (int n = 0; n < 2; ++n) acc[a][b][m][n] = (f32x4){0.f, 0.f, 0.f, 0.f};
        cur = nxt; cA = nA; cB = nB; ++ui;
        if constexpr (ALIGN_EPI) { if (wr == 1) PG8_BAR; }
    }
    PG8_WAIT_V(0);
    if constexpr (!ALIGN_EPI) { if (wr == 0) PG8_BAR; }
    PG8_BAR;
    if constexpr (Epi::AFTER_DRAIN) { E.fused(acc, cur, wr, wc, fr, fq, lds, wid, lane); S.done(cur); }
#undef PG8_SA
#undef PG8_SB
#undef PG8_STAGE
#undef PG8_LDA
#undef PG8_LDB
#undef PG8_MMA
#undef PG8_WAIT_V
#undef PG8_WAIT_L
#undef PG8_BAR
#undef PG8_SCHED
}
}

#define GAS __attribute__((address_space(1)))
#define LAS __attribute__((address_space(3)))
typedef unsigned short bf16;
typedef unsigned v4u __attribute__((ext_vector_type(4)));
typedef float f32x4 __attribute__((ext_vector_type(4)));
typedef short bf16x8 __attribute__((ext_vector_type(8)));
typedef GAS unsigned gu32;
typedef GAS unsigned long long gu64;
#define RLX_AGENT __ATOMIC_RELAXED, __HIP_MEMORY_SCOPE_AGENT
#define LDS_WAIT() asm volatile("s_waitcnt lgkmcnt(0)" ::: "memory")
#define VM_WAIT() asm volatile("s_waitcnt vmcnt(0)" ::: "memory")
__device__ __forceinline__ unsigned long long rt() { return __builtin_amdgcn_s_memrealtime(); }
__device__ __forceinline__ unsigned f2bf(float f) { unsigned u = __builtin_bit_cast(unsigned, f); return (u + 0x7fffu + ((u >> 16) & 1u)) >> 16; }
__device__ __forceinline__ unsigned pk2(float lo, float hi) { return f2bf(lo) | (f2bf(hi) << 16); }

#define XB_TMO      128
#define XB_XCNT(j)  (256  + 64 * (j))
#define XB_XSUB(j)  (1280 + 64 * (j))
#define XB_XGEN(j)  (2304 + 64 * (j))
#define XB_TOP      3328
#define XB_TOPGEN   3392
#define XCD_BAR_WORDS 3456
#define XB_SPIN_CAP (1u << 18)

__device__ __forceinline__ unsigned xb_ld(unsigned* p)              { return __hip_atomic_load(p, __ATOMIC_RELAXED, __HIP_MEMORY_SCOPE_AGENT); }
__device__ __forceinline__ unsigned xb_add(unsigned* p, unsigned v) { return __hip_atomic_fetch_add(p, v, __ATOMIC_RELAXED, __HIP_MEMORY_SCOPE_AGENT); }
__device__ __forceinline__ unsigned xb_xcc_id() { return (unsigned)__builtin_amdgcn_s_getreg((3 << 11) | 20) & 0xFu; }
#define XB_SPIN(cond, bar) do { unsigned _sp = 0; while (cond) { __builtin_amdgcn_s_sleep(1); \
    if ((++_sp & 255u) == 0u) { if (xb_ld(&(bar)[XB_TMO])) break; if (_sp > XB_SPIN_CAP) { atomicAdd(&(bar)[XB_TMO], 1u); break; } } } } while (0)

struct XcdBarrier {
    unsigned* bar; unsigned x;
    volatile LAS unsigned* st;
};

__device__ __forceinline__ XcdBarrier xcd_barrier_post(unsigned* bar, volatile LAS unsigned* st) {
    XcdBarrier b; b.bar = bar; b.x = xb_xcc_id(); b.st = st;
    if (threadIdx.x == 0) (void)xb_add(&bar[XB_XCNT(b.x)], 1u);
    return b;
}
__device__ __forceinline__ void xcd_barrier_complete(unsigned* bar, unsigned x, unsigned& nloc, unsigned& nx) {
    const unsigned G = gridDim.x * gridDim.y * gridDim.z;
    unsigned sum, cnt, mine, sp = 0u;
    for (;;) {
        sum = 0u; cnt = 0u; mine = 0u;
#pragma unroll
        for (unsigned j = 0; j < 16; ++j) { const unsigned c = xb_ld(&bar[XB_XCNT(j)]); sum += c; cnt += (c > 0u) ? 1u : 0u; mine = (j == x) ? c : mine; }
        if (sum == G) break;
        __builtin_amdgcn_s_sleep(1);
        if ((++sp & 255u) == 0u) { if (xb_ld(&bar[XB_TMO])) break; if (sp > XB_SPIN_CAP) { atomicAdd(&bar[XB_TMO], 1u); break; } }
    }
    nloc = mine > 0u ? mine : 1u; nx = cnt > 0u ? cnt : 1u;
}

__device__ __forceinline__ void xcd_barrier(const XcdBarrier& b) {
    asm volatile("s_waitcnt vmcnt(0)" ::: "memory");
    __syncthreads();
    if (threadIdx.x == 0) {
        unsigned* bar = b.bar;
        __builtin_amdgcn_s_waitcnt(0);
        unsigned nloc = b.st[0], nx = b.st[1];
        if (nloc == 0u) { xcd_barrier_complete(bar, b.x, nloc, nx); b.st[0] = nloc; b.st[1] = nx; }
        const unsigned old = xb_add(&bar[XB_XSUB(b.x)], 1u);
        const unsigned gen = old / nloc;
        if (old + 1u == (gen + 1u) * nloc) {
            __builtin_amdgcn_fence(__ATOMIC_RELEASE, "agent");
            asm volatile("s_waitcnt vmcnt(0)" ::: "memory");
            const unsigned og = xb_add(&bar[XB_TOP], 1u);
            const unsigned tg = og / nx;
            if (og + 1u == (tg + 1u) * nx) xb_add(&bar[XB_TOPGEN], 1u);
            else XB_SPIN(xb_ld(&bar[XB_TOPGEN]) == tg, bar);
            __builtin_amdgcn_fence(__ATOMIC_ACQUIRE, "agent");
            xb_add(&bar[XB_XGEN(b.x)], 1u);
            asm volatile("s_waitcnt vmcnt(0)" ::: "memory");
        } else {
            XB_SPIN(xb_ld(&bar[XB_XGEN(b.x)]) == gen, bar);
            __builtin_amdgcn_fence(__ATOMIC_ACQUIRE, "agent");
            asm volatile("s_waitcnt vmcnt(0)" ::: "memory");
        }
    }
    __syncthreads();
}

constexpr int NWAVES = 8;
constexpr int BATCH = 16, SEQ = 2048, D = 1024, M = BATCH * SEQ;
constexpr int SG = 64, SGS = 16, SP = 64;
constexpr int FFD = 2816, FF2 = 5632, AW = 3072, NH = 16, HD = 64, KVQW = 9216;
constexpr int MH = M / 2;
constexpr float DN_ALPHA = 1.4142135623730951f, LN_EPS = 1e-5f;
constexpr float QSCALE = 0.125f * 1.4426950408889634f;

constexpr size_t MiB = 1u << 20;
constexpr size_t WS_CTL = 0, CTL_ZERO_BYTES = 1 * MiB;
constexpr size_t WS_WGLU = 2 * MiB, WS_WOUT = 4 * MiB, WS_WUP0 = 6 * MiB, WS_WUP1 = 17 * MiB, WS_WDN0 = 28 * MiB, WS_WDN1 = 34 * MiB, WS_WKVQ = 40 * MiB, WS_WAO = 58 * MiB;
constexpr size_t WS_H16 = 64 * MiB, WS_Y16 = 128 * MiB, WS_BIG = 192 * MiB, WS_G16 = 368 * MiB, WS_HS = 432 * MiB, WS_RAW = 480 * MiB, WS_S5T = 492 * MiB, WS_END = 512 * MiB;
static_assert(WS_WUP0 + (size_t)FF2 * D * 2 <= WS_WUP1 && WS_WDN0 + (size_t)D * FFD * 2 <= WS_WDN1 && WS_WDN1 + (size_t)D * FFD * 2 <= WS_WKVQ && WS_WKVQ + (size_t)KVQW * D * 2 <= WS_WAO && WS_WAO + 2 * MiB <= WS_H16, "weights map");
static_assert(WS_BIG + (size_t)MH * KVQW * 2 <= WS_RAW && WS_BIG + (size_t)M * FFD * 2 <= WS_G16 && WS_RAW + (size_t)128 * 4 * FF2 * 4 <= WS_S5T, "activation map");
constexpr int CW_BAR = 4096;
constexpr int MAX_LAUNCHES = 8;

constexpr int RING_OFF = 0, RING_BYTES = 131072;
constexpr int XCH_OFF = RING_BYTES, XCH_BYTES = 8192;
constexpr int LDSCTL_OFF = XCH_OFF + XCH_BYTES, MISC_OFF = LDSCTL_OFF + 320;
constexpr int LDS_BYTES = 147456;
static_assert(MISC_OFF + 128 <= LDS_BYTES, "LDS map");

__device__ const unsigned char BUCKET[3][129] = {
{0,1,2,3,4,5,6,7,8,9,10,11,12,13,14,15,16,16,16,16,16,16,17,17,17,17,17,17,17,17,18,18,18,18,18,18,18,18,18,18,19,19,19,19,19,19,19,19,19,19,19,19,19,19,20,20,20,20,20,20,20,20,20,20,20,20,20,20,20,20,20,20,20,21,21,21,21,21,21,21,21,21,21,21,21,21,21,21,21,21,21,21,21,21,21,21,21,21,21,22,22,22,22,22,22,22,22,22,22,22,22,22,22,22,22,22,22,22,22,22,22,22,22,22,22,22,22,22,22},
{0,4,8,12,16,16,17,17,18,18,19,19,19,19,20,20,20,20,20,21,21,21,21,21,21,22,22,22,22,22,22,22,22,22,23,23,23,23,23,23,23,23,23,23,23,23,24,24,24,24,24,24,24,24,24,24,24,24,24,24,24,24,25,25,25,25,25,25,25,25,25,25,25,25,25,25,25,25,25,25,25,25,25,26,26,26,26,26,26,26,26,26,26,26,26,26,26,26,26,26,26,26,26,26,26,26,26,26,26,26,26,26,26,27,27,27,27,27,27,27,27,27,27,27,27,27,27,27,27},
{0,16,18,19,20,21,21,22,22,23,23,23,24,24,24,24,25,25,25,25,25,26,26,26,26,26,26,26,26,27,27,27,27,27,27,27,27,27,27,28,28,28,28,28,28,28,28,28,28,28,28,28,29,29,29,29,29,29,29,29,29,29,29,29,29,29,29,29,29,29,30,30,30,30,30,30,30,30,30,30,30,30,30,30,30,30,30,30,30,30,30,30,30,30,30,31,31,31,31,31,31,31,31,31,31,31,31,31,31,31,31,31,31,31,31,31,31,31,31,31,31,31,31,31,31,31,31,31,31}};

__device__ __forceinline__ double d_exp_small(double x) {
    double y = x * 0.125, t = 1.0, s = 1.0;
#pragma unroll
    for (int i = 1; i <= 14; ++i) { t *= y / (double)i; s += t; }
    s *= s; s *= s; s *= s; return s;
}
__device__ __forceinline__ void d_sincos(double x, double& sn, double& cs) {
    const double TWO_PI = 6.283185307179586476925286766559;
    const double k = __builtin_rint(x / TWO_PI); const double r = x - k * TWO_PI;
    const double q = r * 0.25, q2 = q * q;
    double s = 0.0, c = 0.0, ts = q, tc = 1.0;
#pragma unroll
    for (int i = 0; i < 10; ++i) { s += ts; c += tc; ts *= -q2 / (double)((2 * i + 2) * (2 * i + 3)); tc *= -q2 / (double)((2 * i + 1) * (2 * i + 2)); }
#pragma unroll
    for (int i = 0; i < 2; ++i) { const double s2 = 2.0 * s * c, c2 = c * c - s * s; s = s2; c = c2; }
    sn = s; cs = c;
}
__device__ __forceinline__ float gelu_tanh(float v) { const float z2 = 1.5957691216057308f * (v + 0.044715f * v * v * v); return v * __builtin_amdgcn_rcpf(1.0f + __expf(-z2)); }
__device__ __forceinline__ float wave_sum(float v) {
#pragma unroll
    for (int o = 1; o < 64; o <<= 1) v += __shfl_xor(v, o);
    return v;
}

struct Ptrs {
    const float* in[22]; float* out; unsigned char* ws;
};
__device__ __forceinline__ void p0_transpose_item(const float* W, int K, int N, bf16* WT, int drow0, LAS float* scr, int kb, int nb, int lane) {
    const int k0 = 64 * kb, n0 = 32 * nb;
#pragma unroll 8
    for (int i = 0; i < 32; ++i) { const int kk = 2 * i + (lane >> 5); scr[kk * 33 + (lane & 31)] = W[(size_t)(k0 + kk) * N + n0 + (lane & 31)]; }
    LDS_WAIT(); asm volatile("" ::: "memory");
    const int c = lane & 7;
#pragma unroll
    for (int j = 0; j < 4; ++j) { const int n = (lane >> 3) + 8 * j; const LAS float* s = scr + (8 * c) * 33 + n;
        v4u o; o.x = pk2(s[0 * 33], s[1 * 33]); o.y = pk2(s[2 * 33], s[3 * 33]); o.z = pk2(s[4 * 33], s[5 * 33]); o.w = pk2(s[6 * 33], s[7 * 33]);
        *(GAS v4u*)(WT + (size_t)(drow0 + n) * K + k0 + 8 * c) = o; }
    LDS_WAIT(); asm volatile("" ::: "memory");
}
template <bool UPMAP> __device__ __forceinline__ bool p0_matrix(int& it, const float* W, int K, int N, bf16* WT, int drow_off, LAS float* scr, int lane) {
    const int nblk = N / 32, items = (K / 64) * nblk;
    if (it >= items) { it -= items; return false; }
    const int kb = it / nblk, nb = it % nblk; int drow0 = drow_off + 32 * nb;
    if (UPMAP) { const int n0 = 32 * nb, hh = n0 / FFD, cc = n0 % FFD; drow0 = 256 * (cc / 128) + 128 * hh + (cc % 128); }
    p0_transpose_item(W, K, N, WT, drow0, scr, kb, nb, lane); return true;
}
__device__ __forceinline__ void p0_prologue(const Ptrs& P, LAS unsigned char* lds, int gw, int NGW, int wave, int lane) {
    LAS float* scr = (LAS float*)(lds + RING_OFF + wave * 16384);
    unsigned char* ws = P.ws;
    constexpr int I_DD = 16 * 32, I_UP = 16 * 176, I_DN = 44 * 32, I_KV = 16 * 192, I_Q = 16 * 96;
    constexpr int NITEMS = 3 * I_DD + 2 * I_UP + 2 * I_DN + I_KV + I_Q;
    for (int it0 = gw; it0 < NITEMS; it0 += NGW) {
        int it = it0;
        if (p0_matrix<false>(it, P.in[9], D, D, (bf16*)(ws + WS_WGLU), 0, scr, lane)) continue;
        if (p0_matrix<false>(it, P.in[11], D, D, (bf16*)(ws + WS_WOUT), 0, scr, lane)) continue;
        if (p0_matrix<true>(it, P.in[16], D, FF2, (bf16*)(ws + WS_WUP0), 0, scr, lane)) continue;
        if (p0_matrix<true>(it, P.in[16] + (size_t)D * FF2, D, FF2, (bf16*)(ws + WS_WUP1), 0, scr, lane)) continue;
        if (p0_matrix<false>(it, P.in[19], FFD, D, (bf16*)(ws + WS_WDN0), 0, scr, lane)) continue;
        if (p0_matrix<false>(it, P.in[19] + (size_t)FFD * D, FFD, D, (bf16*)(ws + WS_WDN1), 0, scr, lane)) continue;
        if (p0_matrix<false>(it, P.in[12], D, 2 * AW, (bf16*)(ws + WS_WKVQ), 0, scr, lane)) continue;
        if (p0_matrix<false>(it, P.in[13], D, AW, (bf16*)(ws + WS_WKVQ), 2 * AW, scr, lane)) continue;
        p0_matrix<false>(it, P.in[14], D, D, (bf16*)(ws + WS_WAO), 0, scr, lane);
    }
}

__device__ __forceinline__ void s5_simple(const Ptrs& P, LAS unsigned char* lds, int vcu, int wave, int lane) {
    if (wave >= 4) return;
    const int unit = vcu * 4 + wave; if (unit >= BATCH * SG) return;
    const int b = unit / SG, g = unit % SG, p = lane;
    const float* x = P.in[0]; bf16* Y = (bf16*)(P.ws + WS_Y16);
    LAS float* hs = (LAS float*)(lds + RING_OFF + wave * 16384);
    LAS float* cr = hs + 128; LAS float* ci = cr + 16 * 65;
    for (int i = p; i < 16 * 64; i += 64) { cr[(i / 64) * 65 + (i % 64)] = P.in[6][g * 1024 + i]; ci[(i / 64) * 65 + (i % 64)] = P.in[7][g * 1024 + i]; }
    const double dth = d_exp_small((double)P.in[3][g] * 0.5), dt = dth * dth;
    const double lr = P.in[1][g * SP + p], li = P.in[2][g * SP + p];
    const double mag = d_exp_small(lr * dt); double sn, cs; d_sincos(li * dt, sn, cs);
    const double abr = mag * cs, abi = mag * sn, den = lr * lr + li * li, nr = abr - 1.0;
    const double cor = (nr * lr + abi * li) / den, coi = (abi * lr - nr * li) / den;
    float bbr[16], bbi[16];
#pragma unroll
    for (int h = 0; h < 16; ++h) { const double br = P.in[4][(g * SP + p) * 16 + h], bi = P.in[5][(g * SP + p) * 16 + h]; bbr[h] = (float)(cor * br - coi * bi); bbi[h] = (float)(cor * bi + coi * br); }
    const float ar = (float)abr, ai = (float)abi;
    const float dsk_l = p < 16 ? P.in[8][g * 16 + p] : 0.f;
    float hr = 0.f, hi = 0.f;
    LDS_WAIT(); asm volatile("" ::: "memory");
    for (int t = 0; t < SEQ; ++t) {
        const float* ur = x + ((size_t)(b * SEQ + t)) * D + g * 16;
        const f32x4 u0 = *(const f32x4*)ur, u1 = *(const f32x4*)(ur + 4), u2 = *(const f32x4*)(ur + 8), u3 = *(const f32x4*)(ur + 12);
        const float u[16] = {u0[0], u0[1], u0[2], u0[3], u1[0], u1[1], u1[2], u1[3], u2[0], u2[1], u2[2], u2[3], u3[0], u3[1], u3[2], u3[3]};
        float sr = 0.f, si = 0.f;
#pragma unroll
        for (int h = 0; h < 16; ++h) { sr += bbr[h] * u[h]; si += bbi[h] * u[h]; }
        const float nhr = ar * hr - ai * hi + sr, nhi = ar * hi + ai * hr + si;
        hr = nhr; hi = nhi;
        hs[p] = hr; hs[64 + p] = hi;
        LDS_WAIT(); asm volatile("" ::: "memory");
        if (p < 16) {
            float y = 0.f;
#pragma unroll 8
            for (int q = 0; q < 64; ++q) y += cr[p * 65 + q] * hs[q] - ci[p * 65 + q] * hs[64 + q];
            y += dsk_l * ur[p];
            Y[((size_t)(b * SEQ + t)) * D + g * 16 + p] = (bf16)f2bf(gelu_tanh(y));
        }
        LDS_WAIT(); asm volatile("" ::: "memory");
    }
}

__device__ __forceinline__ void ln_phase(float* Z, const float* gain, const float* bias, bf16* H16, int gw, int NGW, int lane) {
    f32x4 gv[4], bv[4];
#pragma unroll
    for (int j = 0; j < 4; ++j) { gv[j] = *(const f32x4*)(gain + 4 * lane + 256 * j); bv[j] = *(const f32x4*)(bias + 4 * lane + 256 * j); }
    for (int m = gw; m < M; m += NGW) {
        GAS f32x4* zr = (GAS f32x4*)(Z + (size_t)m * D) + lane;
        f32x4 v[4]; float s = 0.f;
#pragma unroll
        for (int j = 0; j < 4; ++j) { v[j] = zr[64 * j]; s += (v[j].x + v[j].y) + (v[j].z + v[j].w); }
        const float mean = wave_sum(s) * (1.f / D); float s2 = 0.f;
#pragma unroll
        for (int j = 0; j < 4; ++j) { v[j] = v[j] - mean; s2 += (v[j].x * v[j].x + v[j].y * v[j].y) + (v[j].z * v[j].z + v[j].w * v[j].w); }
        const float rstd = 1.f / sqrtf(wave_sum(s2) * (1.f / D) + LN_EPS);
#pragma unroll
        for (int j = 0; j < 4; ++j) { v[j] = v[j] * rstd * gv[j] + bv[j]; zr[64 * j] = v[j]; }
        if (H16) { GAS unsigned long long* o8 = (GAS unsigned long long*)(H16 + (size_t)m * D) + lane;
#pragma unroll
            for (int j = 0; j < 4; ++j) o8[64 * j] = (unsigned long long)pk2(v[j].x, v[j].y) | ((unsigned long long)pk2(v[j].z, v[j].w) << 32); }
    }
}

__device__ __forceinline__ void fixup_phase(const float* RAW, const float* cw, const float* cb, bf16* ACT, int gt, int NGT) {
    for (int i = gt; i < 128 * 2 * FFD; i += NGT) {
        const int pm = i / (2 * FFD), j = (i / FFD) & 1, c = i % FFD;
        if ((pm & 7) == 0) continue;
        const int nv = 256 * (c / 128) + (c % 128), ng = nv + 128;
        const float* r0 = RAW + (size_t)(pm * 4) * FF2; const float* rp = RAW + (size_t)((pm - 1) * 4) * FF2;
        float val, gate;
        if (j == 0) { val = cb[c] + cw[c] * r0[nv] + cw[FF2 + c] * rp[3 * FF2 + nv] + cw[2 * FF2 + c] * rp[2 * FF2 + nv];
                      gate = cb[FFD + c] + cw[FFD + c] * r0[ng] + cw[FF2 + FFD + c] * rp[3 * FF2 + ng] + cw[2 * FF2 + FFD + c] * rp[2 * FF2 + ng]; }
        else { val = cb[c] + cw[c] * r0[FF2 + nv] + cw[FF2 + c] * r0[nv] + cw[2 * FF2 + c] * rp[3 * FF2 + nv];
               gate = cb[FFD + c] + cw[FFD + c] * r0[FF2 + ng] + cw[FF2 + FFD + c] * r0[ng] + cw[2 * FF2 + FFD + c] * rp[3 * FF2 + ng]; }
        ACT[(size_t)(pm * 256 + j) * FFD + c] = (bf16)f2bf(gate * __builtin_amdgcn_rcpf(1.0f + __expf(-gate)) * val);
    }
}

namespace att {
typedef float f32x16 __attribute__((ext_vector_type(16)));
typedef short s16x4 __attribute__((ext_vector_type(4)));
typedef short v4i16_t __attribute__((ext_vector_type(4)));
typedef float f32x2_t __attribute__((ext_vector_type(2))); typedef __bf16 bf16x2_t __attribute__((ext_vector_type(2)));
constexpr float LOG2E = 1.4426950408889634f;
constexpr int A_PO = 0, A_PL = 65536, A_BT = 67584, A_WV = 69888, WV_STRIDE = 4608, A_END = A_WV + 8 * WV_STRIDE;
static_assert(A_END <= RING_BYTES, "attention LDS map");
__device__ __forceinline__ int crow(int r, int hi) { return (r & 3) + 8 * (r >> 2) + 4 * hi; }
__device__ __forceinline__ unsigned cvtpk_s(float lo, float hi) { f32x2_t v = {lo, hi}; bf16x2_t b = __builtin_convertvector(v, bf16x2_t); return __builtin_bit_cast(unsigned, b); }
__device__ __forceinline__ s16x4 vtr(LAS unsigned char* p) { return __builtin_bit_cast(s16x4, __builtin_amdgcn_ds_read_tr16_b64_v4i16((LAS v4i16_t*)p)); }
__device__ __forceinline__ float swap_max(float v) { auto rr = __builtin_amdgcn_permlane32_swap(__float_as_uint(v), __float_as_uint(v), false, false); return fmaxf(__uint_as_float(rr[0]), __uint_as_float(rr[1])); }
__device__ __forceinline__ float swap_add(float v) { auto rr = __builtin_amdgcn_permlane32_swap(__float_as_uint(v), __float_as_uint(v), false, false); return __uint_as_float(rr[0]) + __uint_as_float(rr[1]); }

__device__ __forceinline__ void attn_qtile(const bf16* __restrict__ KVQ, bf16* __restrict__ Og, LAS unsigned char* lds, int b, int h, int g, int dil, int r, int s0, int t0, int wave, int lane) {
    const int r32 = lane & 31, hi = lane >> 5;
    const size_t rowb = (size_t)b * SEQ;
    const int colK = g * 1024 + h * 64;
    LAS unsigned char* wv = lds + A_WV + wave * WV_STRIDE;
    LAS unsigned char* vbuf = wv;
    LAS float* wsf = (LAS float*)(wv + 4096);
    const LAS float* bt = (const LAS float*)(lds + A_BT) + g * 192;
    bf16x8 qr[4];
    { const bf16* qrow = KVQ + (rowb + (size_t)(s0 + r32) * dil + r) * KVQW + 2 * AW + colK + hi * 8;
#pragma unroll
      for (int d0 = 0; d0 < 4; ++d0) qr[d0] = *(const bf16x8*)(qrow + d0 * 16); }
    f32x16 o0 = {}, o1 = {}; float m = -1e30f, l = 0.f;
    const int jmin = s0 >= 128 ? 0 : (128 - s0) / 32;
    const LAS unsigned char* vrd = vbuf + ((lane >> 4) & 1) * 32 + (lane & 3) * 8 + (4 * hi + ((lane & 15) >> 2)) * 64;
    for (int j = jmin; j < 5; ++j) {
        const int ks0 = s0 - 128 + 32 * j;
        const bf16* krow = KVQ + (rowb + (size_t)(ks0 + r32) * dil + r) * KVQW + colK + hi * 8;
        bf16x8 kf[4];
#pragma unroll
        for (int d0 = 0; d0 < 4; ++d0) kf[d0] = *(const bf16x8*)(krow + d0 * 16);
        const bf16* vrow = KVQ + (rowb + (size_t)(ks0 + (lane >> 3)) * dil + r) * KVQW + AW + colK + (lane & 7) * 8;
        v4u vv[4];
#pragma unroll
        for (int i = 0; i < 4; ++i) vv[i] = *(const v4u*)(vrow + (size_t)i * 8 * dil * KVQW);
#pragma unroll
        for (int i = 0; i < 4; ++i) *(LAS v4u*)(vbuf + ((lane & 7) >> 2) * 2048 + (8 * i + (lane >> 3)) * 64 + (lane & 3) * 16) = vv[i];
        f32x16 p = {};
#pragma unroll
        for (int d0 = 0; d0 < 4; ++d0) p = __builtin_amdgcn_mfma_f32_32x32x16_bf16(kf[d0], qr[d0], p, 0, 0, 0);
        const LAS float* btl = bt + ((128 - 32 * j) + 32 + r32 - 4 * hi - 27);
        float mt = -1e30f;
#pragma unroll
        for (int rr = 0; rr < 16; ++rr) { p[rr] += btl[27 - ((rr & 3) + 8 * (rr >> 2))]; mt = fmaxf(mt, p[rr]); }
        mt = swap_max(mt);
        const float mn = fmaxf(m, mt), f = __builtin_amdgcn_exp2f(m - mn); m = mn;
        float sum = 0.f;
#pragma unroll
        for (int rr = 0; rr < 16; ++rr) { p[rr] = __builtin_amdgcn_exp2f(p[rr] - mn); sum += p[rr]; }
        l = l * f + sum;
        if (hi == 0) wsf[r32] = f;
        v4u pw0, pw1;
        pw0.x = cvtpk_s(p[0], p[1]); pw0.y = cvtpk_s(p[2], p[3]); pw0.z = cvtpk_s(p[4], p[5]); pw0.w = cvtpk_s(p[6], p[7]);
        pw1.x = cvtpk_s(p[8], p[9]); pw1.y = cvtpk_s(p[10], p[11]); pw1.z = cvtpk_s(p[12], p[13]); pw1.w = cvtpk_s(p[14], p[15]);
#pragma unroll
        for (int rr = 0; rr < 16; ++rr) { const float fr_ = wsf[crow(rr, hi)]; o0[rr] *= fr_; o1[rr] *= fr_; }
#pragma unroll
        for (int ks = 0; ks < 2; ++ks) {
            const bf16x8 pa = __builtin_bit_cast(bf16x8, ks == 0 ? pw0 : pw1);
            { const s16x4 lo = vtr((LAS unsigned char*)vrd + ks * 1024), hh = vtr((LAS unsigned char*)vrd + ks * 1024 + 512);
              const bf16x8 vf = {lo[0], lo[1], lo[2], lo[3], hh[0], hh[1], hh[2], hh[3]};
              o0 = __builtin_amdgcn_mfma_f32_32x32x16_bf16(pa, vf, o0, 0, 0, 0); }
            { const s16x4 lo = vtr((LAS unsigned char*)vrd + 2048 + ks * 1024), hh = vtr((LAS unsigned char*)vrd + 2048 + ks * 1024 + 512);
              const bf16x8 vf = {lo[0], lo[1], lo[2], lo[3], hh[0], hh[1], hh[2], hh[3]};
              o1 = __builtin_amdgcn_mfma_f32_32x32x16_bf16(pa, vf, o1, 0, 0, 0); }
        }
    }
    l = swap_add(l);
    if (hi == 0) { wsf[r32] = __builtin_amdgcn_rcpf(l); wsf[32 + r32] = m + __builtin_amdgcn_logf(l); }
    bf16* stg = (bf16*)vbuf; LAS bf16* stg3 = (LAS bf16*)vbuf;
#pragma unroll
    for (int rr = 0; rr < 16; ++rr) { const int orow = crow(rr, hi); const float rl = wsf[orow];
        stg3[orow * 64 + r32] = (bf16)f2bf(o0[rr] * rl); stg3[orow * 64 + 32 + r32] = (bf16)f2bf(o1[rr] * rl); }
    (void)stg;
    LAS unsigned char* PO = lds + A_PO; LAS float* PL = (LAS float*)(lds + A_PL);
#pragma unroll
    for (int i = 0; i < 4; ++i) {
        const int row = i * 8 + (lane >> 3), ch = lane & 7;
        const v4u v = *(const LAS v4u*)(vbuf + row * 128 + ch * 16);
        const int pos = (s0 + row) * dil + r - t0;
        const float ls = wsf[32 + row];
        if (g == 0) { *(LAS v4u*)(PO + pos * 128 + ch * 16) = v; if (ch == 0) PL[pos] = ls; }
        else {
            const v4u pv = *(const LAS v4u*)(PO + pos * 128 + ch * 16); const float pl = PL[pos];
            const float mx = fmaxf(pl, ls), nl = mx + __builtin_amdgcn_logf(__builtin_amdgcn_exp2f(pl - mx) + __builtin_amdgcn_exp2f(ls - mx));
            const float wp = __builtin_amdgcn_exp2f(pl - nl), w1 = __builtin_amdgcn_exp2f(ls - nl);
            v4u o;
            o.x = cvtpk_s(wp * __uint_as_float(pv.x << 16) + w1 * __uint_as_float(v.x << 16), wp * __uint_as_float(pv.x & 0xffff0000u) + w1 * __uint_as_float(v.x & 0xffff0000u));
            o.y = cvtpk_s(wp * __uint_as_float(pv.y << 16) + w1 * __uint_as_float(v.y << 16), wp * __uint_as_float(pv.y & 0xffff0000u) + w1 * __uint_as_float(v.y & 0xffff0000u));
            o.z = cvtpk_s(wp * __uint_as_float(pv.z << 16) + w1 * __uint_as_float(v.z << 16), wp * __uint_as_float(pv.z & 0xffff0000u) + w1 * __uint_as_float(v.z & 0xffff0000u));
            o.w = cvtpk_s(wp * __uint_as_float(pv.w << 16) + w1 * __uint_as_float(v.w << 16), wp * __uint_as_float(pv.w & 0xffff0000u) + w1 * __uint_as_float(v.w & 0xffff0000u));
            if (g == 1) { *(LAS v4u*)(PO + pos * 128 + ch * 16) = o; if (ch == 0) PL[pos] = nl; }
            else *(v4u*)(Og + (rowb + t0 + pos) * D + h * 64 + ch * 8) = o;
        }
    }
}

__device__ __forceinline__ void attn_phase(const bf16* KVQ, bf16* Og  , const float* rel_bias, LAS unsigned char* lds, int vcu, int tid) {
    const int lane = tid & 63, wave = __builtin_amdgcn_readfirstlane(tid >> 6);
    const int bh = vcu >> 1, b = bh >> 4, h = bh & 15, sub = vcu & 1;
    if (bh >= (MH / SEQ) * NH) return;
    for (int i = tid; i < 3 * 192; i += NWAVES * 64) { const int g = i / 192, st = i % 192 - 32;
        ((LAS float*)(lds + A_BT))[i] = (st >= 0 && st <= 128) ? rel_bias[BUCKET[g][st] * 48 + g * 16 + h] * LOG2E : -1e30f; }
    __syncthreads();
    for (int ui = 0; ui < 2; ++ui) {
        const int blk = ui == 0 ? (sub == 0 ? 0 : 1) : (sub == 0 ? 3 : 2), t0 = blk * 512;
        for (int g = 0; g < 3; ++g) {
            const int dil = g == 0 ? 1 : (g == 1 ? 4 : 16), tpr = 16 / dil;
            for (int qi = 0; qi < 2; ++qi) {
                const int qt = wave + 8 * qi, r = qt / tpr, jj = qt % tpr, s0 = t0 / dil + 32 * jj;
                attn_qtile(KVQ, Og, lds, b, h, g, dil, r, s0, t0, wave, lane);
            }
            __syncthreads();
        }
    }
}
}

struct Args { const float* in[22]; float* out; unsigned char* ws; int ph_lo, ph_hi, li, pad; };
constexpr int N_PHASES = 19;
__global__ void __launch_bounds__(NWAVES * 64, 2) mk_fwd(Args args) {
    extern __shared__ __attribute__((aligned(16))) unsigned char lds_raw[];
    LAS unsigned char* lds = (LAS unsigned char*)lds_raw;
    volatile LAS unsigned* MISC = (volatile LAS unsigned*)(lds + MISC_OFF);
    const int G = gridDim.x, bx = blockIdx.x, vcu = (G % 8 == 0) ? (bx % 8) * (G / 8) + bx / 8 : bx;
    Ptrs P;
#pragma unroll
    for (int i = 0; i < 22; ++i) P.in[i] = args.in[i];
    P.out = args.out; P.ws = args.ws;
    unsigned char* ws = args.ws;
    gu32* ctl = (gu32*)(ws + WS_CTL);
    for (int u = threadIdx.x; u < (LDS_BYTES - LDSCTL_OFF) / 4; u += NWAVES * 64) ((LAS unsigned*)(lds + LDSCTL_OFF))[u] = 0u;
    __syncthreads();
    XcdBarrier bar = xcd_barrier_post((unsigned*)(ctl + CW_BAR) + args.li * XCD_BAR_WORDS, MISC + 8);
    bf16* H16 = (bf16*)(ws + WS_H16); bf16* Y16 = (bf16*)(ws + WS_Y16); bf16* G16 = (bf16*)(ws + WS_G16); bf16* ACT = (bf16*)(ws + WS_BIG); bf16* KVQ = (bf16*)(ws + WS_BIG);
    float* RAW = (float*)(ws + WS_RAW); float* out = args.out;
    const float* ln_g = args.in[20]; const float* ln_b = args.in[21];

    for (int ph = args.ph_lo; ph < args.ph_hi; ++ph) {
        int tid = threadIdx.x; asm volatile("" : "+v"(tid));
        const int lane = tid & 63, wave = __builtin_amdgcn_readfirstlane(tid >> 6);
        const int gw = vcu * NWAVES + wave, NGW = G * NWAVES, gt = vcu * (NWAVES * 64) + tid, NGT = G * NWAVES * 64;
        if (ph == 0) p0_prologue(P, lds, gw, NGW, wave, lane);
        else if (ph == 1) {
#ifndef SKIP_S5
            s5_simple(P, lds, vcu, wave, lane);
#endif
        }
        else if (ph == 2) {
            pg8::Gemm g{Y16, (const bf16*)(ws + WS_WGLU), M, D, D}; pg8::StaticOrder S; S.init(M, D, G, bx);
            pg8::EpiGlu E{Y16, args.in[10], G16, D};
#ifndef SKIP_GLU
            pg8::gemm_phase<pg8::EpiGlu, pg8::StaticOrder, true, true>(lds + RING_OFF, g, S, E, tid);
#endif
        } else if (ph == 3 || ph == 7 || ph == 13 || ph == 17) {
            const bf16* A = ph == 3 ? G16 : (ph == 13 ? Y16 : ACT);
            const bf16* Bt = (const bf16*)(ws + (ph == 3 ? WS_WOUT : ph == 7 ? WS_WDN0 : ph == 13 ? WS_WAO : WS_WDN1));
            const int K = (ph == 7 || ph == 17) ? FFD : D;
            pg8::Gemm g{A, Bt, M, D, K}; pg8::StaticOrder S; S.init(M, D, G, bx);
            pg8::EpiRes E{ph == 3 ? args.in[0] : out, out, D, DN_ALPHA};
#ifndef SKIP_RES
            pg8::gemm_phase<pg8::EpiRes, pg8::StaticOrder, true, true>(lds + RING_OFF, g, S, E, tid);
#endif
        } else if (ph == 4 || ph == 8 || ph == 14 || ph == 18) {
            const int li = ph == 4 ? 0 : ph == 8 ? 1 : ph == 14 ? 2 : 3;
            ln_phase(out, ln_g + li * D, ln_b + li * D, ph == 18 ? (bf16*)nullptr : H16, gw, NGW, lane);
        } else if (ph == 5 || ph == 15) {
            const int layer = ph == 5 ? 0 : 1;
            pg8::Gemm g{H16, (const bf16*)(ws + (layer ? WS_WUP1 : WS_WUP0)), M, FF2, D}; pg8::StaticOrder S; S.init(M, FF2, G, bx);
            pg8::EpiConvGate E{ACT, args.in[17] + (size_t)layer * 3 * FF2, args.in[18] + (size_t)layer * FF2, RAW, (PG8_LAS float*)(lds + XCH_OFF)};
#ifndef SKIP_UP
            pg8::gemm_phase<pg8::EpiConvGate, pg8::StaticOrder, true, true>(lds + RING_OFF, g, S, E, tid);
#endif
        } else if (ph == 6 || ph == 16) {
            const int layer = ph == 6 ? 0 : 1;
            fixup_phase(RAW, args.in[17] + (size_t)layer * 3 * FF2, args.in[18] + (size_t)layer * FF2, ACT, gt, NGT);
        } else if (ph == 9 || ph == 11) {
            const int half = ph == 9 ? 0 : 1;
            pg8::Gemm g{H16 + (size_t)half * MH * D, (const bf16*)(ws + WS_WKVQ), MH, KVQW, D}; pg8::StaticOrder S; S.init(MH, KVQW, G, bx);
            pg8::EpiKVQ E{KVQ, KVQW, 2 * AW, QSCALE};
#ifndef SKIP_KVQ
            pg8::gemm_phase<pg8::EpiKVQ, pg8::StaticOrder, true, true>(lds + RING_OFF, g, S, E, tid);
#endif
        } else if (ph == 10 || ph == 12) {
#ifndef SKIP_ATT
            att::attn_phase(KVQ, Y16 + (size_t)(ph == 10 ? 0 : 1) * MH * D, args.in[15], lds + RING_OFF, vcu, tid);
#endif
        }
        if (ph + 1 < args.ph_hi) xcd_barrier(bar);
    }
}

extern "C" void kernel_launch(void* const* d_in, const int* in_sizes, int n_in, void* d_out, int out_size, void* d_ws, size_t ws_size, hipStream_t stream) {
    static int grid = 0;
    if (grid == 0) {
        if (n_in != 22 || in_sizes[0] != M * D || out_size != M * D || ws_size < WS_END) { fprintf(stderr, "kernel_launch: unexpected shapes / workspace (%d inputs, ws %zu)\n", n_in, ws_size); grid = -1; return; }
        int dev = 0, cus = 0, per_cu = 0;
        if (hipGetDevice(&dev) != hipSuccess || hipDeviceGetAttribute(&cus, hipDeviceAttributeMultiprocessorCount, dev) != hipSuccess) { grid = -1; return; }
        if (hipFuncSetAttribute((const void*)mk_fwd, hipFuncAttributeMaxDynamicSharedMemorySize, LDS_BYTES) != hipSuccess) { grid = -1; return; }
        if (hipOccupancyMaxActiveBlocksPerMultiprocessor(&per_cu, (const void*)mk_fwd, NWAVES * 64, LDS_BYTES) != hipSuccess || per_cu < 1) fprintf(stderr, "kernel_launch: occupancy query reports %d\n", per_cu);
        (void)hipGetLastError();
        grid = cus;
        if (grid != 256) fprintf(stderr, "kernel_launch: %d CUs; the unit schedule expects 256\n", grid);
    }
    if (grid < 0) return;
    if (hipMemsetAsync((char*)d_ws + WS_CTL, 0, CTL_ZERO_BYTES, stream) != hipSuccess) return;
    Args a{};
    for (int i = 0; i < 22; ++i) a.in[i] = (const float*)d_in[i];
    a.out = (float*)d_out; a.ws = (unsigned char*)d_ws;
#ifndef MK_CUTS
#define MK_CUTS {0, N_PHASES}
#endif
    const int cuts[] = MK_CUTS; const int nl = (int)(sizeof(cuts) / sizeof(int)) - 1;
    for (int li = 0; li < nl; ++li) {
        a.ph_lo = cuts[li]; a.ph_hi = cuts[li + 1]; a.li = li;
        hipLaunchKernelGGL(mk_fwd, dim3(grid), dim3(NWAVES * 64), LDS_BYTES, stream, a);
    }
}
```

```cpp
#include <hip/hip_runtime.h>
#include <cstdio>
#include <cstdint>
namespace pg8 {
#define PG8_LAS __attribute__((address_space(3)))
typedef unsigned short bf16_t;
typedef short bf16x8 __attribute__((ext_vector_type(8)));
typedef float f32x4 __attribute__((ext_vector_type(4)));
typedef unsigned u32x4 __attribute__((ext_vector_type(4)));
constexpr int BM = 256, BK = 64, HALF = 128, HTB = HALF * BK * 2  , STAGE_BYTES = 8 * HTB, NXCD = 8, WGM = 8;

__host__ __device__ __forceinline__ int lds_byte(int r, int c) { const int st = (r >> 4) * 2 + (c >> 5), rr = r & 15, cc = c & 31, ob = rr * 64 + cc * 2; return st * 1024 + (ob ^ (((ob >> 9) & 1) << 5)); }
__host__ __device__ __forceinline__ void stage_rc(int b, int& R, int& C) { const int st = b / 1024, sb = b % 1024, swz = sb ^ (((sb >> 9) & 1) << 5); R = (st >> 1) * 16 + swz / 64; C = (st & 1) * 32 + (swz % 64) / 2; }
__host__ __device__ __forceinline__ int perm32(int rho) { const int n = rho >> 4, i = rho & 15; return 8 * (i >> 2) + 4 * n + (i & 3); }

struct Unit { int pm, pn; };
struct Gemm { const bf16_t* A; const bf16_t* Bt; int M, N, K; };

struct StaticOrder {
    int nM, nN, nwg, G, c;
    __host__ __device__ void init(int M, int N, int G_, int c_) { nM = M / BM; nN = N / BM; nwg = nM * nN; G = G_; c = c_; }
    __host__ __device__ bool next(int i, Unit& u) const {
        const long L = (long)i * G + c; if (L >= nwg) return false;
        int wgid = (int)L; { const int q = nwg / NXCD, r = nwg % NXCD, xcd = wgid % NXCD, off = wgid / NXCD; wgid = (xcd < r ? xcd * (q + 1) : r * (q + 1) + (xcd - r) * q) + off; }
        const int nig = WGM * nN, gid = wgid / nig, fm = gid * WGM, gsz = (nM - fm) < WGM ? (nM - fm) : WGM;
        u.pm = fm + ((wgid % nig) % gsz); u.pn = (wgid % nig) / gsz; return true;
    }
    __device__ __forceinline__ void a_ready(const Unit&) const {}
    __device__ __forceinline__ void done(const Unit&) const {}
};
__device__ __forceinline__ unsigned cvt_pk_bf16(float lo, float hi) { unsigned r; asm volatile("v_cvt_pk_bf16_f32 %0, %1, %2" : "=v"(r) : "v"(lo), "v"(hi)); return r; }

__device__ __forceinline__ float bf_lo(unsigned u) { return __uint_as_float(u << 16); }
__device__ __forceinline__ float bf_hi(unsigned u) { return __uint_as_float(u & 0xffff0000u); }
__device__ __forceinline__ float fast_sigmoid(float v) { return __builtin_amdgcn_rcpf(1.0f + __expf(-v)); }
template <int CTRL> __device__ __forceinline__ float dpp_mov(float old, float src) {
    return __uint_as_float((unsigned)__builtin_amdgcn_update_dpp((int)__float_as_uint(old), (int)__float_as_uint(src), CTRL, 0xf, 0xf, false));
}
constexpr int DPP_SHR1 = 0x111, DPP_SHR2 = 0x112, DPP_ROR1 = 0x121, DPP_ROR2 = 0x122;

struct EpiGlu {
    static constexpr bool PERM = true, AFTER_DRAIN = false;
    const bf16_t* Y; const float* bias; bf16_t* O; int ldc;
    __device__ __forceinline__ void operator()(const f32x4 (&acc)[2][2][4][2], const Unit& u, int wr, int wc, int fr, int fq) const {
        const int row0 = u.pm * BM + wr * 64 + fr, col0 = u.pn * BM + wc * 32 + 8 * fq;
        f32x4 bv[2][2];
#pragma unroll
        for (int bj = 0; bj < 2; ++bj)
#pragma unroll
            for (int n = 0; n < 2; ++n) bv[bj][n] = *(const f32x4*)(bias + col0 + bj * HALF + 4 * n);
#pragma unroll
        for (int ai = 0; ai < 2; ++ai)
#pragma unroll
            for (int m = 0; m < 4; ++m) { const size_t off = (size_t)(row0 + ai * HALF + m * 16) * ldc + col0;
#pragma unroll
                for (int bj = 0; bj < 2; ++bj) { const u32x4 yv = *(const u32x4*)(Y + off + bj * HALF);
                    const f32x4 v0 = acc[ai][bj][m][0] + bv[bj][0], v1 = acc[ai][bj][m][1] + bv[bj][1];
                    u32x4 w;
                    w.x = cvt_pk_bf16(bf_lo(yv.x) * fast_sigmoid(v0[0]), bf_hi(yv.x) * fast_sigmoid(v0[1]));
                    w.y = cvt_pk_bf16(bf_lo(yv.y) * fast_sigmoid(v0[2]), bf_hi(yv.y) * fast_sigmoid(v0[3]));
                    w.z = cvt_pk_bf16(bf_lo(yv.z) * fast_sigmoid(v1[0]), bf_hi(yv.z) * fast_sigmoid(v1[1]));
                    w.w = cvt_pk_bf16(bf_lo(yv.w) * fast_sigmoid(v1[2]), bf_hi(yv.w) * fast_sigmoid(v1[3]));
                    *(u32x4*)(O + off + bj * HALF) = w; }
                asm volatile("" ::: "memory"); }
    }
};
struct EpiRes {
    static constexpr bool PERM = false, AFTER_DRAIN = false;
    const float* R; float* Z; int ldc; float alpha;
    __device__ __forceinline__ void operator()(const f32x4 (&acc)[2][2][4][2], const Unit& u, int wr, int wc, int fr, int fq) const {
        const int row0 = u.pm * BM + wr * 64 + fr, col0 = u.pn * BM + wc * 32 + 4 * fq;
#pragma unroll
        for (int ai = 0; ai < 2; ++ai)
#pragma unroll
            for (int m = 0; m < 4; ++m) { const size_t off = (size_t)(row0 + ai * HALF + m * 16) * ldc + col0;
                f32x4 r[2][2];
#pragma unroll
                for (int bj = 0; bj < 2; ++bj)
#pragma unroll
                    for (int n = 0; n < 2; ++n) r[bj][n] = *(const f32x4*)(R + off + bj * HALF + n * 16);
#pragma unroll
                for (int bj = 0; bj < 2; ++bj)
#pragma unroll
                    for (int n = 0; n < 2; ++n) *(f32x4*)(Z + off + bj * HALF + n * 16) = r[bj][n] * alpha + acc[ai][bj][m][n];
                asm volatile("" ::: "memory"); }
    }
};
struct EpiKVQ {
    static constexpr bool PERM = true, AFTER_DRAIN = false;
    bf16_t* O; int ldc; int qcol0; float qscale;
    __device__ __forceinline__ void operator()(const f32x4 (&acc)[2][2][4][2], const Unit& u, int wr, int wc, int fr, int fq) const {
        const int row0 = u.pm * BM + wr * 64 + fr, colt = u.pn * BM, col0 = colt + wc * 32 + 8 * fq; const float sc = colt >= qcol0 ? qscale : 1.0f;
#pragma unroll
        for (int ai = 0; ai < 2; ++ai)
#pragma unroll
            for (int m = 0; m < 4; ++m) { bf16_t* rowp = O + (size_t)(row0 + ai * HALF + m * 16) * ldc + col0;
#pragma unroll
                for (int bj = 0; bj < 2; ++bj) { const f32x4 v0 = acc[ai][bj][m][0] * sc, v1 = acc[ai][bj][m][1] * sc; u32x4 w;
                    w.x = cvt_pk_bf16(v0[0], v0[1]); w.y = cvt_pk_bf16(v0[2], v0[3]); w.z = cvt_pk_bf16(v1[0], v1[1]); w.w = cvt_pk_bf16(v1[2], v1[3]);
                    *(u32x4*)(rowp + bj * HALF) = w; } }
    }
};
struct EpiConvGate {
    static constexpr bool PERM = true, AFTER_DRAIN = false;
    static constexpr int FFD = 2816;
    bf16_t* ACT; const float* cw; const float* cb; float* RAW; PG8_LAS float* X;
    __device__ __forceinline__ void operator()(f32x4 (&acc)[2][2][4][2], const Unit& u, int wr, int wc, int fr, int fq) const {
        const int cl0 = wc * 32 + 8 * fq;
        const int ncol = u.pn * BM + cl0;
        const int cv = u.pn * HALF + cl0;
        if (fr >= 14) {
#pragma unroll
            for (int ai = 0; ai < 2; ++ai) { PG8_LAS float* xp = X + ((((ai * 2 + wr) * 4 + wc) * 2 + (fr - 14)) * 4 + fq) * 16;
#pragma unroll
                for (int bj = 0; bj < 2; ++bj)
#pragma unroll
                    for (int n = 0; n < 2; ++n) *(PG8_LAS f32x4*)(xp + (bj * 2 + n) * 4) = acc[ai][bj][3][n]; }
        }
        if (wr == 0 && fr < 2) { float* rp = RAW + (size_t)(u.pm * 4 + fr) * (2 * FFD) + ncol;
#pragma unroll
            for (int bj = 0; bj < 2; ++bj)
#pragma unroll
                for (int n = 0; n < 2; ++n) *(f32x4*)(rp + bj * HALF + 4 * n) = acc[0][bj][0][n]; }
        if (wr == 1 && fr >= 14) { float* rp = RAW + (size_t)(u.pm * 4 + 2 + (fr - 14)) * (2 * FFD) + ncol;
#pragma unroll
            for (int bj = 0; bj < 2; ++bj)
#pragma unroll
                for (int n = 0; n < 2; ++n) *(f32x4*)(rp + bj * HALF + 4 * n) = acc[1][bj][3][n]; }
        asm volatile("s_waitcnt lgkmcnt(0)" ::: "memory"); __builtin_amdgcn_s_barrier(); asm volatile("" ::: "memory");
        const bool skip01 = (u.pm & 7) != 0;
#pragma unroll
        for (int bj = 0; bj < 2; ++bj)
#pragma unroll
            for (int n = 0; n < 2; ++n) {
                const f32x4 bsv = *(const f32x4*)(cb + bj * FFD + cv + 4 * n);
                const f32x4 w0 = *(const f32x4*)(cw + bj * FFD + cv + 4 * n), w1 = *(const f32x4*)(cw + (2 * FFD) + bj * FFD + cv + 4 * n), w2 = *(const f32x4*)(cw + 2 * (2 * FFD) + bj * FFD + cv + 4 * n);
#pragma unroll
                for (int ai = 0; ai < 2; ++ai) {
                    const int bi = ai * 2 + wr;
                    f32x4 vb = (f32x4){0.f, 0.f, 0.f, 0.f};
                    if (bi != 0) vb = *(const PG8_LAS f32x4*)(X + (((((bi - 1) * 4 + wc) * 2 + (fr & 1)) * 4 + fq)) * 16 + (bj * 2 + n) * 4);
#pragma unroll
                    for (int m = 3; m >= 0; --m) { f32x4 o;
#pragma unroll
                        for (int e = 0; e < 4; ++e) { const float cur = acc[ai][bj][m][n][e], prv = (m == 0) ? vb[e] : acc[ai][bj][m == 0 ? 0 : m - 1][n][e];
                            const float p1 = dpp_mov<DPP_SHR1>(dpp_mov<DPP_ROR1>(0.f, prv), cur), p2 = dpp_mov<DPP_SHR2>(dpp_mov<DPP_ROR2>(0.f, prv), cur);
                            o[e] = bsv[e] + w0[e] * cur + w1[e] * p1 + w2[e] * p2; }
                        acc[ai][bj][m][n] = o; asm volatile("" : "+v"(acc[ai][bj][m][n])); }
                }
                asm volatile("" ::: "memory");
            }
#pragma unroll
        for (int ai = 0; ai < 2; ++ai)
#pragma unroll
            for (int m = 0; m < 4; ++m) {
                u32x4 pk;
                { const f32x4 v0 = acc[ai][0][m][0], v1 = acc[ai][0][m][1], g0 = acc[ai][1][m][0], g1 = acc[ai][1][m][1];
                  pk.x = cvt_pk_bf16(g0[0] * fast_sigmoid(g0[0]) * v0[0], g0[1] * fast_sigmoid(g0[1]) * v0[1]);
                  pk.y = cvt_pk_bf16(g0[2] * fast_sigmoid(g0[2]) * v0[2], g0[3] * fast_sigmoid(g0[3]) * v0[3]);
                  pk.z = cvt_pk_bf16(g1[0] * fast_sigmoid(g1[0]) * v1[0], g1[1] * fast_sigmoid(g1[1]) * v1[1]);
                  pk.w = cvt_pk_bf16(g1[2] * fast_sigmoid(g1[2]) * v1[2], g1[3] * fast_sigmoid(g1[3]) * v1[3]); }
                const int row = u.pm * BM + ai * HALF + wr * 64 + m * 16 + fr;
                if (!(skip01 && ai == 0 && wr == 0 && m == 0 && fr < 2)) *(u32x4*)(ACT + (size_t)row * FFD + cv) = pk;
            }
        asm volatile("s_waitcnt lgkmcnt(0)" ::: "memory"); __builtin_amdgcn_s_barrier(); asm volatile("" ::: "memory");
    }
};

template <class Epi, class Sched, bool ALIGN_EPI = false, bool SP2 = false>
__device__ __forceinline__ void gemm_phase(PG8_LAS unsigned char* lds, const Gemm g, const Sched& S, const Epi& E, const int tid  ) {
    const int wid = __builtin_amdgcn_readfirstlane(tid >> 6), lane = tid & 63, wr = wid >> 2, wc = wid & 3, fr = lane & 15, fq = lane >> 4;
    const int K = g.K, nt = K / BK;
    unsigned voffA[2], voffB[2];
#pragma unroll
    for (int i = 0; i < 2; ++i) { int R, C; stage_rc(tid * 16 + i * 8192, R, C); const int Rb = Epi::PERM ? ((R & ~31) + perm32(R & 31)) : R;
        voffA[i] = (unsigned)(R * K + C) * 2u; voffB[i] = (unsigned)(Rb * K + C) * 2u; }
    const size_t kstep = (size_t)(BK * 2);
    const size_t hstep = (size_t)HALF * K * 2;
    const size_t tstep = 2 * hstep;
    const unsigned ldsw = (unsigned)wid * 1024u;
    const int aoff = lds_byte(wr * 64 + fr, fq * 8), boff = lds_byte(wc * 32 + fr, fq * 8);
#define PG8_SA(b, h) (((b) * 2 + (h)) * HTB)
#define PG8_SB(b, h) ((4 + (b) * 2 + (h)) * HTB)
#define PG8_STAGE(bufoff, gbase, voff) do { _Pragma("unroll") for (int _i = 0; _i < 2; ++_i) \
        __builtin_amdgcn_global_load_lds((const unsigned*)((const char*)(gbase) + (voff)[_i]), (PG8_LAS unsigned*)(lds + (bufoff) + ldsw + _i * 8192), 16, 0, 0); } while (0)
#define PG8_LDA(dst, b, h) do { _Pragma("unroll") for (int m = 0; m < 4; ++m) _Pragma("unroll") for (int k = 0; k < 2; ++k) dst[m][k] = *(const PG8_LAS bf16x8*)(lds + PG8_SA(b, h) + aoff + m * 2048 + k * 1024); } while (0)
#define PG8_LDB(dst, b, h) do { _Pragma("unroll") for (int n = 0; n < 2; ++n) _Pragma("unroll") for (int k = 0; k < 2; ++k) dst[n][k] = *(const PG8_LAS bf16x8*)(lds + PG8_SB(b, h) + boff + n * 2048 + k * 1024); } while (0)
#define PG8_MMA(ai, bj, At, Bt) do { __builtin_amdgcn_s_setprio(1); _Pragma("unroll") for (int m = 0; m < 4; ++m) _Pragma("unroll") for (int n = 0; n < 2; ++n) _Pragma("unroll") for (int k = 0; k < 2; ++k) \
        acc[ai][bj][m][n] = __builtin_amdgcn_mfma_f32_16x16x32_bf16(Bt[n][k], At[m][k], acc[ai][bj][m][n], 0, 0, 0); __builtin_amdgcn_s_setprio(0); } while (0)
#define PG8_WAIT_V(n) asm volatile("s_waitcnt vmcnt(" #n ")" ::: "memory")
#define PG8_WAIT_L(n) asm volatile("s_waitcnt lgkmcnt(" #n ")" ::: "memory")
#define PG8_BAR __builtin_amdgcn_s_barrier()
#define PG8_SCHED __builtin_amdgcn_sched_barrier(0)
    Unit cur, nxt; int ui = 0;
    if (!S.next(0, cur)) return;
    f32x4 acc[2][2][4][2];
#pragma unroll
    for (int a = 0; a < 2; ++a)
#pragma unroll
        for (int b = 0; b < 2; ++b)
#pragma unroll
            for (int m = 0; m < 4; ++m)
#pragma unroll
                for (int n = 0; n < 2; ++n) acc[a][b][m][n] = (f32x4){0.f, 0.f, 0.f, 0.f};
    bf16x8 At[4][2], B0[2][2], B1[2][2];
    const char* cA = (const char*)g.A + (size_t)cur.pm * tstep; const char* cB = (const char*)g.Bt + (size_t)cur.pn * tstep;
    S.a_ready(cur);
    if constexpr (SP2) {
        PG8_STAGE(PG8_SB(0, 0), cB, voffB); PG8_STAGE(PG8_SB(0, 1), cB + hstep, voffB); PG8_STAGE(PG8_SA(0, 0), cA, voffA); PG8_STAGE(PG8_SA(0, 1), cA + hstep, voffA);
        if (wr == 1) PG8_BAR;
        PG8_WAIT_V(2); PG8_BAR;
        PG8_STAGE(PG8_SB(1, 0), cB + kstep, voffB); PG8_STAGE(PG8_SA(1, 0), cA + kstep, voffA); PG8_STAGE(PG8_SB(1, 1), cB + hstep + kstep, voffB);
        PG8_WAIT_V(6); PG8_BAR;
    } else {
        PG8_STAGE(PG8_SB(0, 0), cB, voffB); PG8_STAGE(PG8_SA(0, 0), cA, voffA); PG8_STAGE(PG8_SB(0, 1), cB + hstep, voffB); PG8_STAGE(PG8_SA(0, 1), cA + hstep, voffA);
        if (wr == 1) PG8_BAR;
        PG8_WAIT_V(4); PG8_BAR;
        PG8_STAGE(PG8_SB(1, 0), cB + kstep, voffB); PG8_STAGE(PG8_SA(1, 0), cA + kstep, voffA); PG8_STAGE(PG8_SB(1, 1), cB + hstep + kstep, voffB);
        PG8_WAIT_V(6); PG8_BAR;
    }
    for (;;) {
        const bool has_next = S.next(ui + 1, nxt);
        const char* nA = has_next ? (const char*)g.A + (size_t)nxt.pm * tstep : cA; const char* nB = has_next ? (const char*)g.Bt + (size_t)nxt.pn * tstep : cB;
        for (int t = 0; t < nt; t += 2) {
            const bool last = (t == nt - 2);
            const char* a1 = cA + (size_t)(t + 1) * kstep;
            const char* a2 = last ? nA : cA + (size_t)(t + 2) * kstep; const char* b2 = last ? nB : cB + (size_t)(t + 2) * kstep;
            const char* a3 = a2 + kstep; const char* b3 = b2 + kstep;
            if (last && has_next) S.a_ready(nxt);
            if constexpr (SP2) {
            PG8_LDB(B0, 0, 0); PG8_LDB(B1, 0, 1); PG8_SCHED; PG8_LDA(At, 0, 0); PG8_STAGE(PG8_SA(1, 1), a1 + hstep, voffA);
            PG8_WAIT_V(8); PG8_WAIT_L(0); PG8_BAR; PG8_MMA(0, 0, At, B0); PG8_MMA(0, 1, At, B1); PG8_BAR; PG8_SCHED;
            PG8_LDA(At, 0, 1); PG8_STAGE(PG8_SB(0, 0), b2, voffB); PG8_STAGE(PG8_SB(0, 1), b2 + hstep, voffB); PG8_STAGE(PG8_SA(0, 0), a2, voffA);
            PG8_WAIT_V(8); PG8_WAIT_L(0); PG8_BAR; PG8_MMA(1, 0, At, B0); PG8_MMA(1, 1, At, B1); PG8_BAR; PG8_SCHED;
            PG8_LDB(B0, 1, 0); PG8_LDB(B1, 1, 1); PG8_SCHED; PG8_LDA(At, 1, 0); PG8_STAGE(PG8_SA(0, 1), a2 + hstep, voffA);
            PG8_WAIT_V(8); PG8_WAIT_L(0); PG8_BAR; PG8_MMA(0, 0, At, B0); PG8_MMA(0, 1, At, B1); PG8_BAR; PG8_SCHED;
            PG8_LDA(At, 1, 1); PG8_STAGE(PG8_SB(1, 0), b3, voffB); PG8_STAGE(PG8_SB(1, 1), b3 + hstep, voffB); PG8_STAGE(PG8_SA(1, 0), a3, voffA);
            PG8_WAIT_V(8); PG8_WAIT_L(0); PG8_BAR; PG8_MMA(1, 0, At, B0); PG8_MMA(1, 1, At, B1); PG8_BAR; PG8_SCHED;
            } else {
            PG8_LDB(B0, 0, 0); PG8_SCHED; PG8_LDA(At, 0, 0); PG8_STAGE(PG8_SA(1, 1), a1 + hstep, voffA);
            PG8_WAIT_L(8); PG8_BAR; PG8_WAIT_L(0); PG8_MMA(0, 0, At, B0); PG8_BAR; PG8_SCHED;
            PG8_LDB(B1, 0, 1); PG8_STAGE(PG8_SB(0, 0), b2, voffB);
            PG8_BAR; PG8_WAIT_L(0); PG8_MMA(0, 1, At, B1); PG8_BAR;
            PG8_LDA(At, 0, 1); PG8_STAGE(PG8_SA(0, 0), a2, voffA);
            PG8_BAR; PG8_WAIT_L(0); PG8_MMA(1, 0, At, B0); PG8_BAR; PG8_SCHED;
            PG8_STAGE(PG8_SB(0, 1), b2 + hstep, voffB);
            PG8_WAIT_V(6); PG8_BAR; PG8_MMA(1, 1, At, B1); PG8_BAR;
            PG8_LDB(B0, 1, 0); PG8_SCHED; PG8_LDA(At, 1, 0); PG8_STAGE(PG8_SA(0, 1), a2 + hstep, voffA);
            PG8_WAIT_L(8); PG8_BAR; PG8_WAIT_L(0); PG8_MMA(0, 0, At, B0); PG8_BAR; PG8_SCHED;
            PG8_LDB(B1, 1, 1); PG8_STAGE(PG8_SB(1, 0), b3, voffB);
            PG8_BAR; PG8_WAIT_L(0); PG8_MMA(0, 1, At, B1); PG8_BAR;
            PG8_LDA(At, 1, 1); PG8_STAGE(PG8_SA(1, 0), a3, voffA);
            PG8_BAR; PG8_WAIT_L(0); PG8_MMA(1, 0, At, B0); PG8_BAR; PG8_SCHED;
            PG8_STAGE(PG8_SB(1, 1), b3 + hstep, voffB);
            PG8_WAIT_V(6); PG8_BAR; PG8_MMA(1, 1, At, B1); PG8_BAR;
            }
        }
        if constexpr (ALIGN_EPI) { if (wr == 0) PG8_BAR; }
        if constexpr (!Epi::AFTER_DRAIN) { E(acc, cur, wr, wc, fr, fq); S.done(cur); }
        if (!has_next) break;
#pragma unroll
        for (int a = 0; a < 2; ++a)
#pragma unroll
            for (int b = 0; b < 2; ++b)
#pragma unroll
                for (int m = 0; m < 4; ++m)
#pragma unroll
                    for (int n = 0; n < 2; ++n) acc[a][b][m][n] = (f32x4){0.f, 0.f, 0.f, 0.f};
        cur = nxt; cA = nA; cB = nB; ++ui;
        if constexpr (ALIGN_EPI) { if (wr == 1) PG8_BAR; }
    }
    PG8_WAIT_V(0);
    if constexpr (!ALIGN_EPI) { if (wr == 0) PG8_BAR; }
    PG8_BAR;
    if constexpr (Epi::AFTER_DRAIN) { E.fused(acc, cur, wr, wc, fr, fq, lds, wid, lane); S.done(cur); }
#undef PG8_SA
#undef PG8_SB
#undef PG8_STAGE
#undef PG8_LDA
#undef PG8_LDB
#undef PG8_MMA
#undef PG8_WAIT_V
#undef PG8_WAIT_L
#undef PG8_BAR
#undef PG8_SCHED
}
}

#define GAS __attribute__((address_space(1)))
#define LAS __attribute__((address_space(3)))
typedef unsigned short bf16;
typedef unsigned v4u __attribute__((ext_vector_type(4)));
typedef float f32x4 __attribute__((ext_vector_type(4)));
typedef short bf16x8 __attribute__((ext_vector_type(8)));
typedef GAS unsigned gu32;
typedef GAS unsigned long long gu64;
#define RLX_AGENT __ATOMIC_RELAXED, __HIP_MEMORY_SCOPE_AGENT
#define LDS_WAIT() asm volatile("s_waitcnt lgkmcnt(0)" ::: "memory")
#define VM_WAIT() asm volatile("s_waitcnt vmcnt(0)" ::: "memory")
__device__ __forceinline__ unsigned long long rt() { return __builtin_amdgcn_s_memrealtime(); }
__device__ __forceinline__ unsigned f2bf(float f) { unsigned u = __builtin_bit_cast(unsigned, f); return (u + 0x7fffu + ((u >> 16) & 1u)) >> 16; }
__device__ __forceinline__ unsigned pk2(float lo, float hi) { return f2bf(lo) | (f2bf(hi) << 16); }

#define XB_TMO      128
#define XB_XCNT(j)  (256  + 64 * (j))
#define XB_XSUB(j)  (1280 + 64 * (j))
#define XB_XGEN(j)  (2304 + 64 * (j))
#define XB_TOP      3328
#define XB_TOPGEN   3392
#define XCD_BAR_WORDS 3456
#define XB_SPIN_CAP (1u << 18)

__device__ __forceinline__ unsigned xb_ld(unsigned* p)              { return __hip_atomic_load(p, __ATOMIC_RELAXED, __HIP_MEMORY_SCOPE_AGENT); }
__device__ __forceinline__ unsigned xb_add(unsigned* p, unsigned v) { return __hip_atomic_fetch_add(p, v, __ATOMIC_RELAXED, __HIP_MEMORY_SCOPE_AGENT); }
__device__ __forceinline__ unsigned xb_xcc_id() { return (unsigned)__builtin_amdgcn_s_getreg((3 << 11) | 20) & 0xFu; }
#define XB_SPIN(cond, bar) do { unsigned _sp = 0; while (cond) { __builtin_amdgcn_s_sleep(1); \
    if ((++_sp & 255u) == 0u) { if (xb_ld(&(bar)[XB_TMO])) break; if (_sp > XB_SPIN_CAP) { atomicAdd(&(bar)[XB_TMO], 1u); break; } } } } while (0)

struct XcdBarrier {
    unsigned* bar; unsigned x;
    volatile LAS unsigned* st;
};

__device__ __forceinline__ XcdBarrier xcd_barrier_post(unsigned* bar, volatile LAS unsigned* st) {
    XcdBarrier b; b.bar = bar; b.x = xb_xcc_id(); b.st = st;
    if (threadIdx.x == 0) (void)xb_add(&bar[XB_XCNT(b.x)], 1u);
    return b;
}
__device__ __forceinline__ void xcd_barrier_complete(unsigned* bar, unsigned x, unsigned& nloc, unsigned& nx) {
    const unsigned G = gridDim.x * gridDim.y * gridDim.z;
    unsigned sum, cnt, mine, sp = 0u;
    for (;;) {
        sum = 0u; cnt = 0u; mine = 0u;
#pragma unroll
        for (unsigned j = 0; j < 16; ++j) { const unsigned c = xb_ld(&bar[XB_XCNT(j)]); sum += c; cnt += (c > 0u) ? 1u : 0u; mine = (j == x) ? c : mine; }
        if (sum == G) break;
        __builtin_amdgcn_s_sleep(1);
        if ((++sp & 255u) == 0u) { if (xb_ld(&bar[XB_TMO])) break; if (sp > XB_SPIN_CAP) { atomicAdd(&bar[XB_TMO], 1u); break; } }
    }
    nloc = mine > 0u ? mine : 1u; nx = cnt > 0u ? cnt : 1u;
}

__device__ __forceinline__ void xcd_barrier(const XcdBarrier& b) {
    asm volatile("s_waitcnt vmcnt(0)" ::: "memory");
    __syncthreads();
    if (threadIdx.x == 0) {
        unsigned* bar = b.bar;
        __builtin_amdgcn_s_waitcnt(0);
        unsigned nloc = b.st[0], nx = b.st[1];
        if (nloc == 0u) { xcd_barrier_complete(bar, b.x, nloc, nx); b.st[0] = nloc; b.st[1] = nx; }
        const unsigned old = xb_add(&bar[XB_XSUB(b.x)], 1u);
        const unsigned gen = old / nloc;
        if (old + 1u == (gen + 1u) * nloc) {
            __builtin_amdgcn_fence(__ATOMIC_RELEASE, "agent");
            asm volatile("s_waitcnt vmcnt(0)" ::: "memory");
            const unsigned og = xb_add(&bar[XB_TOP], 1u);
            const unsigned tg = og / nx;
            if (og + 1u == (tg + 1u) * nx) xb_add(&bar[XB_TOPGEN], 1u);
            else XB_SPIN(xb_ld(&bar[XB_TOPGEN]) == tg, bar);
            __builtin_amdgcn_fence(__ATOMIC_ACQUIRE, "agent");
            xb_add(&bar[XB_XGEN(b.x)], 1u);
            asm volatile("s_waitcnt vmcnt(0)" ::: "memory");
        } else {
            XB_SPIN(xb_ld(&bar[XB_XGEN(b.x)]) == gen, bar);
            __builtin_amdgcn_fence(__ATOMIC_ACQUIRE, "agent");
            asm volatile("s_waitcnt vmcnt(0)" ::: "memory");
        }
    }
    __syncthreads();
}

constexpr int NWAVES = 8;
constexpr int BATCH = 16, SEQ = 2048, D = 1024, M = BATCH * SEQ;
constexpr int SG = 64, SGS = 16, SP = 64;
constexpr int FFD = 2816, FF2 = 5632, AW = 3072, NH = 16, HD = 64, KVQW = 9216;
constexpr int MH = M / 2;
constexpr float DN_ALPHA = 1.4142135623730951f, LN_EPS = 1e-5f;
constexpr float QSCALE = 0.125f * 1.4426950408889634f;

constexpr size_t MiB = 1u << 20;
constexpr size_t WS_CTL = 0, CTL_ZERO_BYTES = 1 * MiB;
constexpr size_t WS_WGLU = 2 * MiB, WS_WOUT = 4 * MiB, WS_WUP0 = 6 * MiB, WS_WUP1 = 17 * MiB, WS_WDN0 = 28 * MiB, WS_WDN1 = 34 * MiB, WS_WKVQ = 40 * MiB, WS_WAO = 58 * MiB;
constexpr size_t WS_H16 = 64 * MiB, WS_Y16 = 128 * MiB, WS_BIG = 192 * MiB, WS_G16 = 368 * MiB, WS_HS = 432 * MiB, WS_RAW = 480 * MiB, WS_S5T = 492 * MiB, WS_END = 512 * MiB;
static_assert(WS_WUP0 + (size_t)FF2 * D * 2 <= WS_WUP1 && WS_WDN0 + (size_t)D * FFD * 2 <= WS_WDN1 && WS_WDN1 + (size_t)D * FFD * 2 <= WS_WKVQ && WS_WKVQ + (size_t)KVQW * D * 2 <= WS_WAO && WS_WAO + 2 * MiB <= WS_H16, "weights map");
static_assert(WS_BIG + (size_t)MH * KVQW * 2 <= WS_RAW && WS_BIG + (size_t)M * FFD * 2 <= WS_G16 && WS_RAW + (size_t)128 * 4 * FF2 * 4 <= WS_S5T, "activation map");
constexpr int CW_BAR = 4096;
constexpr int MAX_LAUNCHES = 8;

constexpr int RING_OFF = 0, RING_BYTES = 131072;
constexpr int XCH_OFF = RING_BYTES, XCH_BYTES = 8192;
constexpr int LDSCTL_OFF = XCH_OFF + XCH_BYTES, MISC_OFF = LDSCTL_OFF + 320;
constexpr int LDS_BYTES = 147456;
static_assert(MISC_OFF + 128 <= LDS_BYTES, "LDS map");

__device__ const unsigned char BUCKET[3][129] = {
{0,1,2,3,4,5,6,7,8,9,10,11,12,13,14,15,16,16,16,16,16,16,17,17,17,17,17,17,17,17,18,18,18,18,18,18,18,18,18,18,19,19,19,19,19,19,19,19,19,19,19,19,19,19,20,20,20,20,20,20,20,20,20,20,20,20,20,20,20,20,20,20,20,21,21,21,21,21,21,21,21,21,21,21,21,21,21,21,21,21,21,21,21,21,21,21,21,21,21,22,22,22,22,22,22,22,22,22,22,22,22,22,22,22,22,22,22,22,22,22,22,22,22,22,22,22,22,22,22},
{0,4,8,12,16,16,17,17,18,18,19,19,19,19,20,20,20,20,20,21,21,21,21,21,21,22,22,22,22,22,22,22,22,22,23,23,23,23,23,23,23,23,23,23,23,23,24,24,24,24,24,24,24,24,24,24,24,24,24,24,24,24,25,25,25,25,25,25,25,25,25,25,25,25,25,25,25,25,25,25,25,25,25,26,26,26,26,26,26,26,26,26,26,26,26,26,26,26,26,26,26,26,26,26,26,26,26,26,26,26,26,26,26,27,27,27,27,27,27,27,27,27,27,27,27,27,27,27,27},
{0,16,18,19,20,21,21,22,22,23,23,23,24,24,24,24,25,25,25,25,25,26,26,26,26,26,26,26,26,27,27,27,27,27,27,27,27,27,27,28,28,28,28,28,28,28,28,28,28,28,28,28,29,29,29,29,29,29,29,29,29,29,29,29,29,29,29,29,29,29,30,30,30,30,30,30,30,30,30,30,30,30,30,30,30,30,30,30,30,30,30,30,30,30,30,31,31,31,31,31,31,31,31,31,31,31,31,31,31,31,31,31,31,31,31,31,31,31,31,31,31,31,31,31,31,31,31,31,31}};

__device__ __forceinline__ double d_exp_small(double x) {
    double y = x * 0.125, t = 1.0, s = 1.0;
#pragma unroll
    for (int i = 1; i <= 14; ++i) { t *= y / (double)i; s += t; }
    s *= s; s *= s; s *= s; return s;
}
__device__ __forceinline__ void d_sincos(double x, double& sn, double& cs) {
    const double TWO_PI = 6.283185307179586476925286766559;
    const double k = __builtin_rint(x / TWO_PI); const double r = x - k * TWO_PI;
    const double q = r * 0.25, q2 = q * q;
    double s = 0.0, c = 0.0, ts = q, tc = 1.0;
#pragma unroll
    for (int i = 0; i < 10; ++i) { s += ts; c += tc; ts *= -q2 / (double)((2 * i + 2) * (2 * i + 3)); tc *= -q2 / (double)((2 * i + 1) * (2 * i + 2)); }
#pragma unroll
    for (int i = 0; i < 2; ++i) { const double s2 = 2.0 * s * c, c2 = c * c - s * s; s = s2; c = c2; }
    sn = s; cs = c;
}
__device__ __forceinline__ float gelu_tanh(float v) { const float z2 = 1.5957691216057308f * (v + 0.044715f * v * v * v); return v * __builtin_amdgcn_rcpf(1.0f + __expf(-z2)); }
__device__ __forceinline__ float wave_sum(float v) {
#pragma unroll
    for (int o = 1; o < 64; o <<= 1) v += __shfl_xor(v, o);
    return v;
}

struct Ptrs {
    const float* in[22]; float* out; unsigned char* ws;
};
__device__ __forceinline__ void p0_transpose_item(const float* W, int K, int N, bf16* WT, int drow0, LAS float* scr, int kb, int nb, int lane) {
    const int k0 = 64 * kb, n0 = 32 * nb;
#pragma unroll 8
    for (int i = 0; i < 32; ++i) { const int kk = 2 * i + (lane >> 5); scr[kk * 33 + (lane & 31)] = W[(size_t)(k0 + kk) * N + n0 + (lane & 31)]; }
    LDS_WAIT(); asm volatile("" ::: "memory");
    const int c = lane & 7;
#pragma unroll
    for (int j = 0; j < 4; ++j) { const int n = (lane >> 3) + 8 * j; const LAS float* s = scr + (8 * c) * 33 + n;
        v4u o; o.x = pk2(s[0 * 33], s[1 * 33]); o.y = pk2(s[2 * 33], s[3 * 33]); o.z = pk2(s[4 * 33], s[5 * 33]); o.w = pk2(s[6 * 33], s[7 * 33]);
        *(GAS v4u*)(WT + (size_t)(drow0 + n) * K + k0 + 8 * c) = o; }
    LDS_WAIT(); asm volatile("" ::: "memory");
}
template <bool UPMAP> __device__ __forceinline__ bool p0_matrix(int& it, const float* W, int K, int N, bf16* WT, int drow_off, LAS float* scr, int lane) {
    const int nblk = N / 32, items = (K / 64) * nblk;
    if (it >= items) { it -= items; return false; }
    const int kb = it / nblk, nb = it % nblk; int drow0 = drow_off + 32 * nb;
    if (UPMAP) { const int n0 = 32 * nb, hh = n0 / FFD, cc = n0 % FFD; drow0 = 256 * (cc / 128) + 128 * hh + (cc % 128); }
    p0_transpose_item(W, K, N, WT, drow0, scr, kb, nb, lane); return true;
}
__device__ __forceinline__ void p0_prologue(const Ptrs& P, LAS unsigned char* lds, int gw, int NGW, int wave, int lane) {
    LAS float* scr = (LAS float*)(lds + RING_OFF + wave * 16384);
    unsigned char* ws = P.ws;
    constexpr int I_DD = 16 * 32, I_UP = 16 * 176, I_DN = 44 * 32, I_KV = 16 * 192, I_Q = 16 * 96;
    constexpr int NITEMS = 3 * I_DD + 2 * I_UP + 2 * I_DN + I_KV + I_Q;
    for (int it0 = gw; it0 < NITEMS; it0 += NGW) {
        int it = it0;
        if (p0_matrix<false>(it, P.in[9], D, D, (bf16*)(ws + WS_WGLU), 0, scr, lane)) continue;
        if (p0_matrix<false>(it, P.in[11], D, D, (bf16*)(ws + WS_WOUT), 0, scr, lane)) continue;
        if (p0_matrix<true>(it, P.in[16], D, FF2, (bf16*)(ws + WS_WUP0), 0, scr, lane)) continue;
        if (p0_matrix<true>(it, P.in[16] + (size_t)D * FF2, D, FF2, (bf16*)(ws + WS_WUP1), 0, scr, lane)) continue;
        if (p0_matrix<false>(it, P.in[19], FFD, D, (bf16*)(ws + WS_WDN0), 0, scr, lane)) continue;
        if (p0_matrix<false>(it, P.in[19] + (size_t)FFD * D, FFD, D, (bf16*)(ws + WS_WDN1), 0, scr, lane)) continue;
        if (p0_matrix<false>(it, P.in[12], D, 2 * AW, (bf16*)(ws + WS_WKVQ), 0, scr, lane)) continue;
        if (p0_matrix<false>(it, P.in[13], D, AW, (bf16*)(ws + WS_WKVQ), 2 * AW, scr, lane)) continue;
        p0_matrix<false>(it, P.in[14], D, D, (bf16*)(ws + WS_WAO), 0, scr, lane);
    }
}

namespace s5 {
typedef float f32x16 __attribute__((ext_vector_type(16)));
constexpr size_t T_TK = 0, T_TS = 2 * MiB, T_TO = 10 * MiB, T_TA = 18 * MiB;
__device__ __forceinline__ void disc(const Ptrs& P, int g, int p, double& ar, double& ai, double& cor, double& coi) {
    const double dth = d_exp_small((double)P.in[3][g] * 0.5), dt = dth * dth;
    const double lr = P.in[1][g * SP + p], li = P.in[2][g * SP + p];
    ar = lr * dt; ai = li * dt;
    const double mag = d_exp_small(ar); double sn, cs; d_sincos(ai, sn, cs);
    const double abr = mag * cs, abi = mag * sn, den = lr * lr + li * li, nr = abr - 1.0;
    cor = (nr * lr + abi * li) / den; coi = (abi * lr - nr * li) / den;
}
__device__ __forceinline__ void cpow(double ar, double ai, int k, double& pr, double& pi) { const double mag = d_exp_small((double)k * ar); double sn, cs; d_sincos((double)k * ai, sn, cs); pr = mag * cs; pi = mag * sn; }

__device__ __forceinline__ void tables(const Ptrs& P, LAS unsigned char* lds, int gw, int NGW, int wave, int lane) {
    unsigned char* tb = P.ws + WS_S5T;
    bf16* TK = (bf16*)(tb + T_TK); bf16* TS = (bf16*)(tb + T_TS); bf16* TO = (bf16*)(tb + T_TO); float* TA = (float*)(tb + T_TA);
    LAS float* scr = (LAS float*)(lds + RING_OFF + wave * 16384);
    for (int it = gw; it < SG * 32; it += NGW) {
        const int g = it >> 5, k = it & 31, p = lane;
        double ar, ai, cor, coi; disc(P, g, p, ar, ai, cor, coi);
        double pr, pi; cpow(ar, ai, k, pr, pi);
        const float zr = (float)(pr * cor - pi * coi), zi = (float)(pr * coi + pi * cor);
        float br[16], bi[16];
#pragma unroll
        for (int h = 0; h < 16; ++h) { const float b_r = P.in[4][(g * SP + p) * 16 + h], b_i = P.in[5][(g * SP + p) * 16 + h]; br[h] = zr * b_r - zi * b_i; bi[h] = zr * b_i + zi * b_r; }
        for (int ho = 0; ho < 16; ++ho) {
            const float cr = P.in[6][(g * 16 + ho) * SP + p], ci = P.in[7][(g * 16 + ho) * SP + p];
#pragma unroll
            for (int h = 0; h < 16; ++h) { float v = wave_sum(cr * br[h] - ci * bi[h]); if (k == 0 && h == ho) v += P.in[8][g * 16 + ho]; if (lane == 0) scr[ho * 16 + h] = v; }
        }
        LDS_WAIT(); asm volatile("" ::: "memory");
#pragma unroll
        for (int q = 0; q < 4; ++q) { const int v = lane + 64 * q, ho = v >> 4, hi = v & 15; const bf16 val = (bf16)f2bf(scr[v]);
            if (k <= 30) TK[(((size_t)g * 32 + (k + 1)) * 64 + (ho + 32 * (hi >> 3))) * 8 + (hi & 7)] = val;
            TK[(((size_t)g * 32 + k) * 64 + (16 + ho + 32 * (hi >> 3))) * 8 + (hi & 7)] = val;
            if (k == 0) TK[(((size_t)g * 32 + 0) * 64 + (ho + 32 * (hi >> 3))) * 8 + (hi & 7)] = 0; }
        LDS_WAIT(); asm volatile("" ::: "memory");
    }
    const int gt = gw * 64 + lane, NGT = NGW * 64;
    for (int it = gt; it < SG * 4 * 32 * 64; it += NGT) {
        const int l2 = it & 63, j = (it >> 6) & 31, rt = (it >> 11) & 3, g = it >> 13;
        const int R = 32 * rt + (l2 & 31), ri = R >> 6, p = R & 63;
        double ar, ai, cor, coi; disc(P, g, p, ar, ai, cor, coi);
        double pr, pi; cpow(ar, ai, 31 - j, pr, pi);
        const double zr = pr * cor - pi * coi, zi = pr * coi + pi * cor;
        unsigned w[4];
#pragma unroll
        for (int q = 0; q < 4; ++q) { float v[2];
#pragma unroll
            for (int e = 0; e < 2; ++e) { const int hi = 8 * (l2 >> 5) + 2 * q + e; const double b_r = P.in[4][(g * SP + p) * 16 + hi], b_i = P.in[5][(g * SP + p) * 16 + hi];
                v[e] = (float)(ri == 0 ? zr * b_r - zi * b_i : zr * b_i + zi * b_r); }
            w[q] = pk2(v[0], v[1]); }
        *(v4u*)(TS + (size_t)it * 8) = (v4u){w[0], w[1], w[2], w[3]};
    }
    for (int it = gt; it < SG * 16 * 8 * 64; it += NGT) {
        const int l2 = it & 63, ks = (it >> 6) & 7, rt = (it >> 9) & 15, g = it >> 13;
        const int row = l2 & 31, ii = row >> 4, ho = row & 15, i = 2 * rt + ii;
        float v[8];
#pragma unroll
        for (int jj = 0; jj < 8; ++jj) { const int R = 16 * ks + 8 * (l2 >> 5) + jj, ri = R >> 6, p = R & 63;
            double ar, ai, cor, coi; disc(P, g, p, ar, ai, cor, coi);
            double pr, pi; cpow(ar, ai, i + 1, pr, pi);
            const double cr = P.in[6][(g * 16 + ho) * SP + p], ci = P.in[7][(g * 16 + ho) * SP + p];
            v[jj] = (float)(ri == 0 ? cr * pr - ci * pi : -(cr * pi + ci * pr)); }
        *(v4u*)(TO + (size_t)it * 8) = (v4u){pk2(v[0], v[1]), pk2(v[2], v[3]), pk2(v[4], v[5]), pk2(v[6], v[7])};
    }
    for (int it = gt; it < SG * SP; it += NGT) { double ar, ai, cor, coi; disc(P, it >> 6, it & 63, ar, ai, cor, coi); double pr, pi; cpow(ar, ai, 32, pr, pi); TA[2 * it] = (float)pr; TA[2 * it + 1] = (float)pi; }
}

__device__ __forceinline__ bf16x8 load_u(const float* xp) { const f32x4 a = *(const f32x4*)xp, b = *(const f32x4*)(xp + 4); const v4u w = {pk2(a[0], a[1]), pk2(a[2], a[3]), pk2(b[0], b[1]), pk2(b[2], b[3])}; return __builtin_bit_cast(bf16x8, w); }

__device__ __forceinline__ void phase_a(const Ptrs& P, float* HS, int vcu, int wave, int lane) {
    const int g = 8 * (vcu & 7) + wave, bh = vcu >> 3, b = bh >> 1, half = bh & 1, cc = lane & 31, hk = lane >> 5, c = half * 32 + cc;
    const bf16* TS = (const bf16*)(P.ws + WS_S5T + T_TS) + (size_t)g * 4 * 32 * 64 * 8 + lane * 8;
    const float* xp = P.in[0] + ((size_t)(b * SEQ + 32 * c)) * D + 16 * g + 8 * hk;
    f32x16 acc[4] = {};
#pragma unroll 4
    for (int j = 0; j < 32; ++j) {
        const bf16x8 u = load_u(xp + (size_t)j * D);
#pragma unroll
        for (int rt = 0; rt < 4; ++rt) acc[rt] = __builtin_amdgcn_mfma_f32_32x32x16_bf16(*(const bf16x8*)(TS + ((size_t)rt * 32 + j) * 512), u, acc[rt], 0, 0, 0);
    }
    float* hp = HS + (((size_t)(b * SG + g)) * 64 + c) * 128 + 4 * hk;
#pragma unroll
    for (int rt = 0; rt < 4; ++rt)
#pragma unroll
        for (int qd = 0; qd < 4; ++qd) *(f32x4*)(hp + 32 * rt + 8 * qd) = (f32x4){acc[rt][4 * qd], acc[rt][4 * qd + 1], acc[rt][4 * qd + 2], acc[rt][4 * qd + 3]};
}

__device__ __forceinline__ void phase_b(const Ptrs& P, float* HS, int vcu, int tid) {
    if (tid >= 256) return;
    const int idx = vcu * 256 + tid, b = idx >> 12, g = (idx >> 6) & 63, p = idx & 63;
    const float* TA = (const float*)(P.ws + WS_S5T + T_TA); const float ar = TA[2 * (g * SP + p)], ai = TA[2 * (g * SP + p) + 1];
    float* hp = HS + ((size_t)(b * SG + g)) * 64 * 128 + p;
    float hr = 0.f, hi = 0.f;
    for (int c0 = 0; c0 < 64; c0 += 16) {
        float sr[16], si[16];
#pragma unroll
        for (int i = 0; i < 16; ++i) { sr[i] = hp[(size_t)(c0 + i) * 128]; si[i] = hp[(size_t)(c0 + i) * 128 + 64]; }
#pragma unroll
        for (int i = 0; i < 16; ++i) { hp[(size_t)(c0 + i) * 128] = hr; hp[(size_t)(c0 + i) * 128 + 64] = hi;
            const float nr = ar * hr - ai * hi + sr[i], ni = ar * hi + ai * hr + si[i]; hr = nr; hi = ni; }
    }
}

__device__ __forceinline__ void phase_c(const Ptrs& P, const float* HS, bf16* Y, int vcu, int wave, int lane) {
    const int g = 8 * (vcu & 7) + wave, bh = vcu >> 3, b = bh >> 1, half = bh & 1, cc = lane & 31, hk = lane >> 5, c = half * 32 + cc;
    const bf16* TK = (const bf16*)(P.ws + WS_S5T + T_TK) + (size_t)g * 32 * 512 + lane * 8;
    const bf16* TO = (const bf16*)(P.ws + WS_S5T + T_TO) + (size_t)g * 16 * 8 * 512 + lane * 8;
    const float* xp = P.in[0] + ((size_t)(b * SEQ + 32 * c)) * D + 16 * g + 8 * hk;
    const float* hp = HS + (((size_t)(b * SG + g)) * 64 + c) * 128 + 8 * hk;
    bf16x8 U[32], H[8];
#pragma unroll
    for (int j = 0; j < 32; ++j) U[j] = load_u(xp + (size_t)j * D);
#pragma unroll
    for (int ks = 0; ks < 8; ++ks) H[ks] = load_u(hp + 16 * ks);
    bf16* yp = Y + ((size_t)(b * SEQ + 32 * c)) * D + 16 * g + 4 * hk;
#pragma unroll
    for (int rt = 0; rt < 16; ++rt) {
        f32x16 acc = {};
#pragma unroll
        for (int j = 0; j < 2 * rt + 2; ++j) acc = __builtin_amdgcn_mfma_f32_32x32x16_bf16(*(const bf16x8*)(TK + (size_t)(2 * rt - j + 1) * 512), U[j], acc, 0, 0, 0);
#pragma unroll
        for (int ks = 0; ks < 8; ++ks) acc = __builtin_amdgcn_mfma_f32_32x32x16_bf16(*(const bf16x8*)(TO + (size_t)(rt * 8 + ks) * 512), H[ks], acc, 0, 0, 0);
#pragma unroll
        for (int qd = 0; qd < 4; ++qd) {
            const unsigned w0 = pk2(gelu_tanh(acc[4 * qd]), gelu_tanh(acc[4 * qd + 1])), w1 = pk2(gelu_tanh(acc[4 * qd + 2]), gelu_tanh(acc[4 * qd + 3]));
            *(unsigned long long*)(yp + (size_t)(2 * rt + (qd >> 1)) * D + 8 * (qd & 1)) = (unsigned long long)w0 | ((unsigned long long)w1 << 32); }
        asm volatile("" ::: "memory");
    }
}
}

__device__ __forceinline__ void ln_phase(float* Z, const float* gain, const float* bias, bf16* H16, int gw, int NGW, int lane) {
    f32x4 gv[4], bv[4];
#pragma unroll
    for (int j = 0; j < 4; ++j) { gv[j] = *(const f32x4*)(gain + 4 * lane + 256 * j); bv[j] = *(const f32x4*)(bias + 4 * lane + 256 * j); }
    for (int m = gw; m < M; m += NGW) {
        GAS f32x4* zr = (GAS f32x4*)(Z + (size_t)m * D) + lane;
        f32x4 v[4]; float s = 0.f;
#pragma unroll
        for (int j = 0; j < 4; ++j) { v[j] = zr[64 * j]; s += (v[j].x + v[j].y) + (v[j].z + v[j].w); }
        const float mean = wave_sum(s) * (1.f / D); float s2 = 0.f;
#pragma unroll
        for (int j = 0; j < 4; ++j) { v[j] = v[j] - mean; s2 += (v[j].x * v[j].x + v[j].y * v[j].y) + (v[j].z * v[j].z + v[j].w * v[j].w); }
        const float rstd = 1.f / sqrtf(wave_sum(s2) * (1.f / D) + LN_EPS);
#pragma unroll
        for (int j = 0; j < 4; ++j) { v[j] = v[j] * rstd * gv[j] + bv[j]; zr[64 * j] = v[j]; }
        if (H16) { GAS unsigned long long* o8 = (GAS unsigned long long*)(H16 + (size_t)m * D) + lane;
#pragma unroll
            for (int j = 0; j < 4; ++j) o8[64 * j] = (unsigned long long)pk2(v[j].x, v[j].y) | ((unsigned long long)pk2(v[j].z, v[j].w) << 32); }
    }
}

__device__ __forceinline__ void fixup_phase(const float* RAW, const float* cw, const float* cb, bf16* ACT, int gt, int NGT) {
    for (int i = gt; i < 128 * 2 * FFD; i += NGT) {
        const int pm = i / (2 * FFD), j = (i / FFD) & 1, c = i % FFD;
        if ((pm & 7) == 0) continue;
        const int nv = 256 * (c / 128) + (c % 128), ng = nv + 128;
        const float* r0 = RAW + (size_t)(pm * 4) * FF2; const float* rp = RAW + (size_t)((pm - 1) * 4) * FF2;
        float val, gate;
        if (j == 0) { val = cb[c] + cw[c] * r0[nv] + cw[FF2 + c] * rp[3 * FF2 + nv] + cw[2 * FF2 + c] * rp[2 * FF2 + nv];
                      gate = cb[FFD + c] + cw[FFD + c] * r0[ng] + cw[FF2 + FFD + c] * rp[3 * FF2 + ng] + cw[2 * FF2 + FFD + c] * rp[2 * FF2 + ng]; }
        else { val = cb[c] + cw[c] * r0[FF2 + nv] + cw[FF2 + c] * r0[nv] + cw[2 * FF2 + c] * rp[3 * FF2 + nv];
               gate = cb[FFD + c] + cw[FFD + c] * r0[FF2 + ng] + cw[FF2 + FFD + c] * r0[ng] + cw[2 * FF2 + FFD + c] * rp[3 * FF2 + ng]; }
        ACT[(size_t)(pm * 256 + j) * FFD + c] = (bf16)f2bf(gate * __builtin_amdgcn_rcpf(1.0f + __expf(-gate)) * val);
    }
}

namespace att {
typedef float f32x16 __attribute__((ext_vector_type(16)));
typedef short s16x4 __attribute__((ext_vector_type(4)));
typedef short v4i16_t __attribute__((ext_vector_type(4)));
typedef float f32x2_t __attribute__((ext_vector_type(2))); typedef __bf16 bf16x2_t __attribute__((ext_vector_type(2)));
constexpr float LOG2E = 1.4426950408889634f;
constexpr int A_PO = 0, A_PL = 65536, A_BT = 67584, A_WV = 69888, WV_STRIDE = 4608, A_END = A_WV + 8 * WV_STRIDE;
static_assert(A_END <= RING_BYTES, "attention LDS map");
__device__ __forceinline__ int crow(int r, int hi) { return (r & 3) + 8 * (r >> 2) + 4 * hi; }
__device__ __forceinline__ unsigned cvtpk_s(float lo, float hi) { f32x2_t v = {lo, hi}; bf16x2_t b = __builtin_convertvector(v, bf16x2_t); return __builtin_bit_cast(unsigned, b); }
__device__ __forceinline__ s16x4 vtr(LAS unsigned char* p) { return __builtin_bit_cast(s16x4, __builtin_amdgcn_ds_read_tr16_b64_v4i16((LAS v4i16_t*)p)); }
__device__ __forceinline__ float swap_max(float v) { auto rr = __builtin_amdgcn_permlane32_swap(__float_as_uint(v), __float_as_uint(v), false, false); return fmaxf(__uint_as_float(rr[0]), __uint_as_float(rr[1])); }
__device__ __forceinline__ float swap_add(float v) { auto rr = __builtin_amdgcn_permlane32_swap(__float_as_uint(v), __float_as_uint(v), false, false); return __uint_as_float(rr[0]) + __uint_as_float(rr[1]); }

__device__ __forceinline__ void attn_qtile(const bf16* __restrict__ KVQ, bf16* __restrict__ Og, LAS unsigned char* lds, int b, int h, int g, int dil, int r, int s0, int t0, int wave, int lane) {
    const int r32 = lane & 31, hi = lane >> 5;
    const size_t rowb = (size_t)b * SEQ;
    const int colK = g * 1024 + h * 64;
    LAS unsigned char* wv = lds + A_WV + wave * WV_STRIDE;
    LAS unsigned char* vbuf = wv;
    LAS float* wsf = (LAS float*)(wv + 4096);
    const LAS float* bt = (const LAS float*)(lds + A_BT) + g * 192;
    bf16x8 qr[4];
    { const bf16* qrow = KVQ + (rowb + (size_t)(s0 + r32) * dil + r) * KVQW + 2 * AW + colK + hi * 8;
#pragma unroll
      for (int d0 = 0; d0 < 4; ++d0) qr[d0] = *(const bf16x8*)(qrow + d0 * 16); }
    f32x16 o0 = {}, o1 = {}; float m = -1e30f, l = 0.f;
    const int jmin = s0 >= 128 ? 0 : (128 - s0) / 32;
    const LAS unsigned char* vrd = vbuf + ((lane >> 4) & 1) * 32 + (lane & 3) * 8 + (4 * hi + ((lane & 15) >> 2)) * 64;
    for (int j = jmin; j < 5; ++j) {
        const int ks0 = s0 - 128 + 32 * j;
        const bf16* krow = KVQ + (rowb + (size_t)(ks0 + r32) * dil + r) * KVQW + colK + hi * 8;
        bf16x8 kf[4];
#pragma unroll
        for (int d0 = 0; d0 < 4; ++d0) kf[d0] = *(const bf16x8*)(krow + d0 * 16);
        const bf16* vrow = KVQ + (rowb + (size_t)(ks0 + (lane >> 3)) * dil + r) * KVQW + AW + colK + (lane & 7) * 8;
        v4u vv[4];
#pragma unroll
        for (int i = 0; i < 4; ++i) vv[i] = *(const v4u*)(vrow + (size_t)i * 8 * dil * KVQW);
#pragma unroll
        for (int i = 0; i < 4; ++i) *(LAS v4u*)(vbuf + ((lane & 7) >> 2) * 2048 + (8 * i + (lane >> 3)) * 64 + (lane & 3) * 16) = vv[i];
        f32x16 p = {};
#pragma unroll
        for (int d0 = 0; d0 < 4; ++d0) p = __builtin_amdgcn_mfma_f32_32x32x16_bf16(kf[d0], qr[d0], p, 0, 0, 0);
        const LAS float* btl = bt + ((128 - 32 * j) + 32 + r32 - 4 * hi - 27);
        float mt = -1e30f;
#pragma unroll
        for (int rr = 0; rr < 16; ++rr) { p[rr] += btl[27 - ((rr & 3) + 8 * (rr >> 2))]; mt = fmaxf(mt, p[rr]); }
        mt = swap_max(mt);
        const float mn = fmaxf(m, mt), f = __builtin_amdgcn_exp2f(m - mn); m = mn;
        float sum = 0.f;
#pragma unroll
        for (int rr = 0; rr < 16; ++rr) { p[rr] = __builtin_amdgcn_exp2f(p[rr] - mn); sum += p[rr]; }
        l = l * f + sum;
        if (hi == 0) wsf[r32] = f;
        v4u pw0, pw1;
        pw0.x = cvtpk_s(p[0], p[1]); pw0.y = cvtpk_s(p[2], p[3]); pw0.z = cvtpk_s(p[4], p[5]); pw0.w = cvtpk_s(p[6], p[7]);
        pw1.x = cvtpk_s(p[8], p[9]); pw1.y = cvtpk_s(p[10], p[11]); pw1.z = cvtpk_s(p[12], p[13]); pw1.w = cvtpk_s(p[14], p[15]);
#pragma unroll
        for (int rr = 0; rr < 16; ++rr) { const float fr_ = wsf[crow(rr, hi)]; o0[rr] *= fr_; o1[rr] *= fr_; }
#pragma unroll
        for (int ks = 0; ks < 2; ++ks) {
            const bf16x8 pa = __builtin_bit_cast(bf16x8, ks == 0 ? pw0 : pw1);
            { const s16x4 lo = vtr((LAS unsigned char*)vrd + ks * 1024), hh = vtr((LAS unsigned char*)vrd + ks * 1024 + 512);
              const bf16x8 vf = {lo[0], lo[1], lo[2], lo[3], hh[0], hh[1], hh[2], hh[3]};
              o0 = __builtin_amdgcn_mfma_f32_32x32x16_bf16(pa, vf, o0, 0, 0, 0); }
            { const s16x4 lo = vtr((LAS unsigned char*)vrd + 2048 + ks * 1024), hh = vtr((LAS unsigned char*)vrd + 2048 + ks * 1024 + 512);
              const bf16x8 vf = {lo[0], lo[1], lo[2], lo[3], hh[0], hh[1], hh[2], hh[3]};
              o1 = __builtin_amdgcn_mfma_f32_32x32x16_bf16(pa, vf, o1, 0, 0, 0); }
        }
    }
    l = swap_add(l);
    if (hi == 0) { wsf[r32] = __builtin_amdgcn_rcpf(l); wsf[32 + r32] = m + __builtin_amdgcn_logf(l); }
    bf16* stg = (bf16*)vbuf; LAS bf16* stg3 = (LAS bf16*)vbuf;
#pragma unroll
    for (int rr = 0; rr < 16; ++rr) { const int orow = crow(rr, hi); const float rl = wsf[orow];
        stg3[orow * 64 + r32] = (bf16)f2bf(o0[rr] * rl); stg3[orow * 64 + 32 + r32] = (bf16)f2bf(o1[rr] * rl); }
    (void)stg;
    LAS unsigned char* PO = lds + A_PO; LAS float* PL = (LAS float*)(lds + A_PL);
#pragma unroll
    for (int i = 0; i < 4; ++i) {
        const int row = i * 8 + (lane >> 3), ch = lane & 7;
        const v4u v = *(const LAS v4u*)(vbuf + row * 128 + ch * 16);
        const int pos = (s0 + row) * dil + r - t0;
        const float ls = wsf[32 + row];
        if (g == 0) { *(LAS v4u*)(PO + pos * 128 + ch * 16) = v; if (ch == 0) PL[pos] = ls; }
        else {
            const v4u pv = *(const LAS v4u*)(PO + pos * 128 + ch * 16); const float pl = PL[pos];
            const float mx = fmaxf(pl, ls), nl = mx + __builtin_amdgcn_logf(__builtin_amdgcn_exp2f(pl - mx) + __builtin_amdgcn_exp2f(ls - mx));
            const float wp = __builtin_amdgcn_exp2f(pl - nl), w1 = __builtin_amdgcn_exp2f(ls - nl);
            v4u o;
            o.x = cvtpk_s(wp * __uint_as_float(pv.x << 16) + w1 * __uint_as_float(v.x << 16), wp * __uint_as_float(pv.x & 0xffff0000u) + w1 * __uint_as_float(v.x & 0xffff0000u));
            o.y = cvtpk_s(wp * __uint_as_float(pv.y << 16) + w1 * __uint_as_float(v.y << 16), wp * __uint_as_float(pv.y & 0xffff0000u) + w1 * __uint_as_float(v.y & 0xffff0000u));
            o.z = cvtpk_s(wp * __uint_as_float(pv.z << 16) + w1 * __uint_as_float(v.z << 16), wp * __uint_as_float(pv.z & 0xffff0000u) + w1 * __uint_as_float(v.z & 0xffff0000u));
            o.w = cvtpk_s(wp * __uint_as_float(pv.w << 16) + w1 * __uint_as_float(v.w << 16), wp * __uint_as_float(pv.w & 0xffff0000u) + w1 * __uint_as_float(v.w & 0xffff0000u));
            if (g == 1) { *(LAS v4u*)(PO + pos * 128 + ch * 16) = o; if (ch == 0) PL[pos] = nl; }
            else *(v4u*)(Og + (rowb + t0 + pos) * D + h * 64 + ch * 8) = o;
        }
    }
}

__device__ __forceinline__ void attn_phase(const bf16* KVQ, bf16* Og  , const float* rel_bias, LAS unsigned char* lds, int vcu, int tid) {
    const int lane = tid & 63, wave = __builtin_amdgcn_readfirstlane(tid >> 6);
    const int bh = vcu >> 1, b = bh >> 4, h = bh & 15, sub = vcu & 1;
    if (bh >= (MH / SEQ) * NH) return;
    for (int i = tid; i < 3 * 192; i += NWAVES * 64) { const int g = i / 192, st = i % 192 - 32;
        ((LAS float*)(lds + A_BT))[i] = (st >= 0 && st <= 128) ? rel_bias[BUCKET[g][st] * 48 + g * 16 + h] * LOG2E : -1e30f; }
    __syncthreads();
    for (int ui = 0; ui < 2; ++ui) {
        const int blk = ui == 0 ? (sub == 0 ? 0 : 1) : (sub == 0 ? 3 : 2), t0 = blk * 512;
        for (int g = 0; g < 3; ++g) {
            const int dil = g == 0 ? 1 : (g == 1 ? 4 : 16), tpr = 16 / dil;
            for (int qi = 0; qi < 2; ++qi) {
                const int qt = wave + 8 * qi, r = qt / tpr, jj = qt % tpr, s0 = t0 / dil + 32 * jj;
                attn_qtile(KVQ, Og, lds, b, h, g, dil, r, s0, t0, wave, lane);
            }
            __syncthreads();
        }
    }
}
}

struct Args { const float* in[22]; float* out; unsigned char* ws; int ph_lo, ph_hi, li, pad; };
enum { PH_PRO = 0, PH_S5A, PH_S5B, PH_S5C, PH_GLU, PH_OUT, PH_LN0, PH_UP0, PH_FIX0, PH_DN0, PH_LN1, PH_KVQ0, PH_ATT0, PH_KVQ1, PH_ATT1, PH_AO, PH_LN2, PH_UP1, PH_FIX1, PH_DN1, PH_LN3, N_PHASES };
__global__ void __launch_bounds__(NWAVES * 64, 2) mk_fwd(Args args) {
    extern __shared__ __attribute__((aligned(16))) unsigned char lds_raw[];
    LAS unsigned char* lds = (LAS unsigned char*)lds_raw;
    volatile LAS unsigned* MISC = (volatile LAS unsigned*)(lds + MISC_OFF);
    const int G = gridDim.x, bx = blockIdx.x, vcu = (G % 8 == 0) ? (bx % 8) * (G / 8) + bx / 8 : bx;
    Ptrs P;
#pragma unroll
    for (int i = 0; i < 22; ++i) P.in[i] = args.in[i];
    P.out = args.out; P.ws = args.ws;
    unsigned char* ws = args.ws;
    gu32* ctl = (gu32*)(ws + WS_CTL);
    for (int u = threadIdx.x; u < (LDS_BYTES - LDSCTL_OFF) / 4; u += NWAVES * 64) ((LAS unsigned*)(lds + LDSCTL_OFF))[u] = 0u;
    __syncthreads();
    XcdBarrier bar = xcd_barrier_post((unsigned*)(ctl + CW_BAR) + args.li * XCD_BAR_WORDS, MISC + 8);
    bf16* H16 = (bf16*)(ws + WS_H16); bf16* Y16 = (bf16*)(ws + WS_Y16); bf16* G16 = (bf16*)(ws + WS_G16); bf16* ACT = (bf16*)(ws + WS_BIG); bf16* KVQ = (bf16*)(ws + WS_BIG);
    float* RAW = (float*)(ws + WS_RAW); float* HS = (float*)(ws + WS_HS); float* out = args.out;
    const float* ln_g = args.in[20]; const float* ln_b = args.in[21];

    for (int ph = args.ph_lo; ph < args.ph_hi; ++ph) {
        int tid = threadIdx.x; asm volatile("" : "+v"(tid));
        const int lane = tid & 63, wave = __builtin_amdgcn_readfirstlane(tid >> 6);
        const int gw = vcu * NWAVES + wave, NGW = G * NWAVES, gt = vcu * (NWAVES * 64) + tid, NGT = G * NWAVES * 64;
        if (ph == PH_PRO) { p0_prologue(P, lds, gw, NGW, wave, lane); s5::tables(P, lds, gw, NGW, wave, lane); }
        else if (ph == PH_S5A) s5::phase_a(P, HS, vcu, wave, lane);
        else if (ph == PH_S5B) s5::phase_b(P, HS, vcu, tid);
        else if (ph == PH_S5C) s5::phase_c(P, HS, Y16, vcu, wave, lane);
        else if (ph == PH_GLU) {
            pg8::Gemm g{Y16, (const bf16*)(ws + WS_WGLU), M, D, D}; pg8::StaticOrder S; S.init(M, D, G, bx);
            pg8::EpiGlu E{Y16, args.in[10], G16, D};
            pg8::gemm_phase<pg8::EpiGlu, pg8::StaticOrder, true, true>(lds + RING_OFF, g, S, E, tid);
        } else if (ph == PH_OUT || ph == PH_DN0 || ph == PH_AO || ph == PH_DN1) {
            const bf16* A = ph == PH_OUT ? G16 : (ph == PH_AO ? Y16 : ACT);
            const bf16* Bt = (const bf16*)(ws + (ph == PH_OUT ? WS_WOUT : ph == PH_DN0 ? WS_WDN0 : ph == PH_AO ? WS_WAO : WS_WDN1));
            const int K = (ph == PH_DN0 || ph == PH_DN1) ? FFD : D;
            pg8::Gemm g{A, Bt, M, D, K}; pg8::StaticOrder S; S.init(M, D, G, bx);
            pg8::EpiRes E{ph == PH_OUT ? args.in[0] : out, out, D, DN_ALPHA};
            pg8::gemm_phase<pg8::EpiRes, pg8::StaticOrder, true, true>(lds + RING_OFF, g, S, E, tid);
        } else if (ph == PH_LN0 || ph == PH_LN1 || ph == PH_LN2 || ph == PH_LN3) {
            const int li = ph == PH_LN0 ? 0 : ph == PH_LN1 ? 1 : ph == PH_LN2 ? 2 : 3;
            ln_phase(out, ln_g + li * D, ln_b + li * D, ph == PH_LN3 ? (bf16*)nullptr : H16, gw, NGW, lane);
        } else if (ph == PH_UP0 || ph == PH_UP1) {
            const int layer = ph == PH_UP0 ? 0 : 1;
            pg8::Gemm g{H16, (const bf16*)(ws + (layer ? WS_WUP1 : WS_WUP0)), M, FF2, D}; pg8::StaticOrder S; S.init(M, FF2, G, bx);
            pg8::EpiConvGate E{ACT, args.in[17] + (size_t)layer * 3 * FF2, args.in[18] + (size_t)layer * FF2, RAW, (PG8_LAS float*)(lds + XCH_OFF)};
            pg8::gemm_phase<pg8::EpiConvGate, pg8::StaticOrder, true, true>(lds + RING_OFF, g, S, E, tid);
        } else if (ph == PH_FIX0 || ph == PH_FIX1) {
            const int layer = ph == PH_FIX0 ? 0 : 1;
            fixup_phase(RAW, args.in[17] + (size_t)layer * 3 * FF2, args.in[18] + (size_t)layer * FF2, ACT, gt, NGT);
        } else if (ph == PH_KVQ0 || ph == PH_KVQ1) {
            const int half = ph == PH_KVQ0 ? 0 : 1;
            pg8::Gemm g{H16 + (size_t)half * MH * D, (const bf16*)(ws + WS_WKVQ), MH, KVQW, D}; pg8::StaticOrder S; S.init(MH, KVQW, G, bx);
            pg8::EpiKVQ E{KVQ, KVQW, 2 * AW, QSCALE};
            pg8::gemm_phase<pg8::EpiKVQ, pg8::StaticOrder, true, true>(lds + RING_OFF, g, S, E, tid);
        } else if (ph == PH_ATT0 || ph == PH_ATT1) {
            att::attn_phase(KVQ, Y16 + (size_t)(ph == PH_ATT0 ? 0 : 1) * MH * D, args.in[15], lds + RING_OFF, vcu, tid);
        }
        if (ph + 1 < args.ph_hi) xcd_barrier(bar);
    }
}

extern "C" void kernel_launch(void* const* d_in, const int* in_sizes, int n_in, void* d_out, int out_size, void* d_ws, size_t ws_size, hipStream_t stream) {
    static int grid = 0;
    if (grid == 0) {
        if (n_in != 22 || in_sizes[0] != M * D || out_size != M * D || ws_size < WS_END) { fprintf(stderr, "kernel_launch: unexpected shapes / workspace (%d inputs, ws %zu)\n", n_in, ws_size); grid = -1; return; }
        int dev = 0, cus = 0, per_cu = 0;
        if (hipGetDevice(&dev) != hipSuccess || hipDeviceGetAttribute(&cus, hipDeviceAttributeMultiprocessorCount, dev) != hipSuccess) { grid = -1; return; }
        if (hipFuncSetAttribute((const void*)mk_fwd, hipFuncAttributeMaxDynamicSharedMemorySize, LDS_BYTES) != hipSuccess) { grid = -1; return; }
        if (hipOccupancyMaxActiveBlocksPerMultiprocessor(&per_cu, (const void*)mk_fwd, NWAVES * 64, LDS_BYTES) != hipSuccess || per_cu < 1) fprintf(stderr, "kernel_launch: occupancy query reports %d\n", per_cu);
        (void)hipGetLastError();
        grid = cus;
        if (grid != 256) fprintf(stderr, "kernel_launch: %d CUs; the unit schedule expects 256\n", grid);
    }
    if (grid < 0) return;
    if (hipMemsetAsync((char*)d_ws + WS_CTL, 0, CTL_ZERO_BYTES, stream) != hipSuccess) return;
    Args a{};
    for (int i = 0; i < 22; ++i) a.in[i] = (const float*)d_in[i];
    a.out = (float*)d_out; a.ws = (unsigned char*)d_ws;
#ifndef MK_CUTS
#define MK_CUTS {0, N_PHASES}
#endif
    const int cuts[] = MK_CUTS; const int nl = (int)(sizeof(cuts) / sizeof(int)) - 1;
    for (int li = 0; li < nl; ++li) {
        a.ph_lo = cuts[li]; a.ph_hi = cuts[li + 1]; a.li = li;
        hipLaunchKernelGGL(mk_fwd, dim3(grid), dim3(NWAVES * 64), LDS_BYTES, stream, a);
    }
}
```

```cpp
#include <hip/hip_runtime.h>
#include <cstdio>
#include <cstdint>
namespace pg8 {
#define PG8_LAS __attribute__((address_space(3)))
typedef unsigned short bf16_t;
typedef short bf16x8 __attribute__((ext_vector_type(8)));
typedef float f32x4 __attribute__((ext_vector_type(4)));
typedef unsigned u32x4 __attribute__((ext_vector_type(4)));
constexpr int BM = 256, BK = 64, HALF = 128, HTB = HALF * BK * 2  , STAGE_BYTES = 8 * HTB, NXCD = 8, WGM = 8;

__host__ __device__ __forceinline__ int lds_byte(int r, int c) { const int st = (r >> 4) * 2 + (c >> 5), rr = r & 15, cc = c & 31, ob = rr * 64 + cc * 2; return st * 1024 + (ob ^ (((ob >> 9) & 1) << 5)); }
__host__ __device__ __forceinline__ void stage_rc(int b, int& R, int& C) { const int st = b / 1024, sb = b % 1024, swz = sb ^ (((sb >> 9) & 1) << 5); R = (st >> 1) * 16 + swz / 64; C = (st & 1) * 32 + (swz % 64) / 2; }
__host__ __device__ __forceinline__ int perm32(int rho) { const int n = rho >> 4, i = rho & 15; return 8 * (i >> 2) + 4 * n + (i & 3); }

struct Unit { int pm, pn; };
struct Gemm { const bf16_t* A; const bf16_t* Bt; int M, N, K; };

struct StaticOrder {
    int nM, nN, nwg, G, c;
    __host__ __device__ void init(int M, int N, int G_, int c_) { nM = M / BM; nN = N / BM; nwg = nM * nN; G = G_; c = c_; }
    __host__ __device__ bool next(int i, Unit& u) const {
        const long L = (long)i * G + c; if (L >= nwg) return false;
        int wgid = (int)L; { const int q = nwg / NXCD, r = nwg % NXCD, xcd = wgid % NXCD, off = wgid / NXCD; wgid = (xcd < r ? xcd * (q + 1) : r * (q + 1) + (xcd - r) * q) + off; }
        const int nig = WGM * nN, gid = wgid / nig, fm = gid * WGM, gsz = (nM - fm) < WGM ? (nM - fm) : WGM;
        u.pm = fm + ((wgid % nig) % gsz); u.pn = (wgid % nig) / gsz; return true;
    }
    __device__ __forceinline__ void a_ready(const Unit&) const {}
    __device__ __forceinline__ void done(const Unit&) const {}
};
__device__ __forceinline__ unsigned cvt_pk_bf16(float lo, float hi) { unsigned r; asm volatile("v_cvt_pk_bf16_f32 %0, %1, %2" : "=v"(r) : "v"(lo), "v"(hi)); return r; }

__device__ __forceinline__ float bf_lo(unsigned u) { return __uint_as_float(u << 16); }
__device__ __forceinline__ float bf_hi(unsigned u) { return __uint_as_float(u & 0xffff0000u); }
__device__ __forceinline__ float fast_sigmoid(float v) { return __builtin_amdgcn_rcpf(1.0f + __expf(-v)); }
template <int CTRL> __device__ __forceinline__ float dpp_mov(float old, float src) {
    return __uint_as_float((unsigned)__builtin_amdgcn_update_dpp((int)__float_as_uint(old), (int)__float_as_uint(src), CTRL, 0xf, 0xf, false));
}
constexpr int DPP_SHR1 = 0x111, DPP_SHR2 = 0x112, DPP_ROR1 = 0x121, DPP_ROR2 = 0x122;

struct EpiGlu {
    static constexpr bool PERM = true, AFTER_DRAIN = false;
    const bf16_t* Y; const float* bias; bf16_t* O; int ldc;
    __device__ __forceinline__ void operator()(const f32x4 (&acc)[2][2][4][2], const Unit& u, int wr, int wc, int fr, int fq) const {
        const int row0 = u.pm * BM + wr * 64 + fr, col0 = u.pn * BM + wc * 32 + 8 * fq;
        f32x4 bv[2][2];
#pragma unroll
        for (int bj = 0; bj < 2; ++bj)
#pragma unroll
            for (int n = 0; n < 2; ++n) bv[bj][n] = *(const f32x4*)(bias + col0 + bj * HALF + 4 * n);
#pragma unroll
        for (int ai = 0; ai < 2; ++ai)
#pragma unroll
            for (int m = 0; m < 4; ++m) { const size_t off = (size_t)(row0 + ai * HALF + m * 16) * ldc + col0;
#pragma unroll
                for (int bj = 0; bj < 2; ++bj) { const u32x4 yv = *(const u32x4*)(Y + off + bj * HALF);
                    const f32x4 v0 = acc[ai][bj][m][0] + bv[bj][0], v1 = acc[ai][bj][m][1] + bv[bj][1];
                    u32x4 w;
                    w.x = cvt_pk_bf16(bf_lo(yv.x) * fast_sigmoid(v0[0]), bf_hi(yv.x) * fast_sigmoid(v0[1]));
                    w.y = cvt_pk_bf16(bf_lo(yv.y) * fast_sigmoid(v0[2]), bf_hi(yv.y) * fast_sigmoid(v0[3]));
                    w.z = cvt_pk_bf16(bf_lo(yv.z) * fast_sigmoid(v1[0]), bf_hi(yv.z) * fast_sigmoid(v1[1]));
                    w.w = cvt_pk_bf16(bf_lo(yv.w) * fast_sigmoid(v1[2]), bf_hi(yv.w) * fast_sigmoid(v1[3]));
                    *(u32x4*)(O + off + bj * HALF) = w; }
                asm volatile("" ::: "memory"); }
    }
};
struct EpiRes {
    static constexpr bool PERM = false, AFTER_DRAIN = false;
    const float* R; float* Z; int ldc; float alpha;
    __device__ __forceinline__ void operator()(const f32x4 (&acc)[2][2][4][2], const Unit& u, int wr, int wc, int fr, int fq) const {
        const int row0 = u.pm * BM + wr * 64 + fr, col0 = u.pn * BM + wc * 32 + 4 * fq;
#pragma unroll
        for (int ai = 0; ai < 2; ++ai)
#pragma unroll
            for (int m = 0; m < 4; ++m) { const size_t off = (size_t)(row0 + ai * HALF + m * 16) * ldc + col0;
                f32x4 r[2][2];
#pragma unroll
                for (int bj = 0; bj < 2; ++bj)
#pragma unroll
                    for (int n = 0; n < 2; ++n) r[bj][n] = *(const f32x4*)(R + off + bj * HALF + n * 16);
#pragma unroll
                for (int bj = 0; bj < 2; ++bj)
#pragma unroll
                    for (int n = 0; n < 2; ++n) *(f32x4*)(Z + off + bj * HALF + n * 16) = r[bj][n] * alpha + acc[ai][bj][m][n];
                asm volatile("" ::: "memory"); }
    }
};
struct EpiKVQ {
    static constexpr bool PERM = true, AFTER_DRAIN = false;
    bf16_t* O; float qscale;
    __device__ __forceinline__ void operator()(const f32x4 (&acc)[2][2][4][2], const Unit& u, int wr, int wc, int fr, int fq) const {
        const int colt = u.pn * BM, kind = colt / 3072, g = (colt % 3072) >> 10, lg = 2 * g, nsl = 2048 >> lg;
        const float sc = kind == 2 ? qscale : 1.0f;
#pragma unroll
        for (int ai = 0; ai < 2; ++ai)
#pragma unroll
            for (int m = 0; m < 4; ++m) { const int R = u.pm * BM + ai * HALF + wr * 64 + m * 16 + fr, b = R >> 11, t = R & 2047, rho = (t & ((1 << lg) - 1)) * nsl + (t >> lg);
#pragma unroll
                for (int bj = 0; bj < 2; ++bj) { const int h = ((colt + bj * HALF + wc * 32) >> 6) & 15, d = (wc & 1) * 32 + 8 * fq;
                    const f32x4 v0 = acc[ai][bj][m][0] * sc, v1 = acc[ai][bj][m][1] * sc; u32x4 w;
                    w.x = cvt_pk_bf16(v0[0], v0[1]); w.y = cvt_pk_bf16(v0[2], v0[3]); w.z = cvt_pk_bf16(v1[0], v1[1]); w.w = cvt_pk_bf16(v1[2], v1[3]);
                    *(u32x4*)(O + ((size_t)((((kind * 3 + g) * 8 + b) * 16 + h) * 2048 + rho)) * 64 + d) = w; } }
    }
};
struct EpiConvGate {
    static constexpr bool PERM = true, AFTER_DRAIN = false;
    static constexpr int FFD = 2816;
    bf16_t* ACT; const float* cw; const float* cb; float* RAW; PG8_LAS float* X;
    __device__ __forceinline__ void operator()(f32x4 (&acc)[2][2][4][2], const Unit& u, int wr, int wc, int fr, int fq) const {
        const int cl0 = wc * 32 + 8 * fq;
        const int ncol = u.pn * BM + cl0;
        const int cv = u.pn * HALF + cl0;
        if (fr >= 14) {
#pragma unroll
            for (int ai = 0; ai < 2; ++ai) { PG8_LAS float* xp = X + ((((ai * 2 + wr) * 4 + wc) * 2 + (fr - 14)) * 4 + fq) * 16;
#pragma unroll
                for (int bj = 0; bj < 2; ++bj)
#pragma unroll
                    for (int n = 0; n < 2; ++n) *(PG8_LAS f32x4*)(xp + (bj * 2 + n) * 4) = acc[ai][bj][3][n]; }
        }
        if (wr == 0 && fr < 2) { float* rp = RAW + (size_t)(u.pm * 4 + fr) * (2 * FFD) + ncol;
#pragma unroll
            for (int bj = 0; bj < 2; ++bj)
#pragma unroll
                for (int n = 0; n < 2; ++n) *(f32x4*)(rp + bj * HALF + 4 * n) = acc[0][bj][0][n]; }
        if (wr == 1 && fr >= 14) { float* rp = RAW + (size_t)(u.pm * 4 + 2 + (fr - 14)) * (2 * FFD) + ncol;
#pragma unroll
            for (int bj = 0; bj < 2; ++bj)
#pragma unroll
                for (int n = 0; n < 2; ++n) *(f32x4*)(rp + bj * HALF + 4 * n) = acc[1][bj][3][n]; }
        asm volatile("s_waitcnt lgkmcnt(0)" ::: "memory"); __builtin_amdgcn_s_barrier(); asm volatile("" ::: "memory");
        const bool skip01 = (u.pm & 7) != 0;
#pragma unroll
        for (int bj = 0; bj < 2; ++bj)
#pragma unroll
            for (int n = 0; n < 2; ++n) {
                const f32x4 bsv = *(const f32x4*)(cb + bj * FFD + cv + 4 * n);
                const f32x4 w0 = *(const f32x4*)(cw + bj * FFD + cv + 4 * n), w1 = *(const f32x4*)(cw + (2 * FFD) + bj * FFD + cv + 4 * n), w2 = *(const f32x4*)(cw + 2 * (2 * FFD) + bj * FFD + cv + 4 * n);
#pragma unroll
                for (int ai = 0; ai < 2; ++ai) {
                    const int bi = ai * 2 + wr;
                    f32x4 vb = (f32x4){0.f, 0.f, 0.f, 0.f};
                    if (bi != 0) vb = *(const PG8_LAS f32x4*)(X + (((((bi - 1) * 4 + wc) * 2 + (fr & 1)) * 4 + fq)) * 16 + (bj * 2 + n) * 4);
#pragma unroll
                    for (int m = 3; m >= 0; --m) { f32x4 o;
#pragma unroll
                        for (int e = 0; e < 4; ++e) { const float cur = acc[ai][bj][m][n][e], prv = (m == 0) ? vb[e] : acc[ai][bj][m == 0 ? 0 : m - 1][n][e];
                            const float p1 = dpp_mov<DPP_SHR1>(dpp_mov<DPP_ROR1>(0.f, prv), cur), p2 = dpp_mov<DPP_SHR2>(dpp_mov<DPP_ROR2>(0.f, prv), cur);
                            o[e] = bsv[e] + w0[e] * cur + w1[e] * p1 + w2[e] * p2; }
                        acc[ai][bj][m][n] = o; asm volatile("" : "+v"(acc[ai][bj][m][n])); }
                }
                asm volatile("" ::: "memory");
            }
#pragma unroll
        for (int ai = 0; ai < 2; ++ai)
#pragma unroll
            for (int m = 0; m < 4; ++m) {
                u32x4 pk;
                { const f32x4 v0 = acc[ai][0][m][0], v1 = acc[ai][0][m][1], g0 = acc[ai][1][m][0], g1 = acc[ai][1][m][1];
                  pk.x = cvt_pk_bf16(g0[0] * fast_sigmoid(g0[0]) * v0[0], g0[1] * fast_sigmoid(g0[1]) * v0[1]);
                  pk.y = cvt_pk_bf16(g0[2] * fast_sigmoid(g0[2]) * v0[2], g0[3] * fast_sigmoid(g0[3]) * v0[3]);
                  pk.z = cvt_pk_bf16(g1[0] * fast_sigmoid(g1[0]) * v1[0], g1[1] * fast_sigmoid(g1[1]) * v1[1]);
                  pk.w = cvt_pk_bf16(g1[2] * fast_sigmoid(g1[2]) * v1[2], g1[3] * fast_sigmoid(g1[3]) * v1[3]); }
                const int row = u.pm * BM + ai * HALF + wr * 64 + m * 16 + fr;
                if (!(skip01 && ai == 0 && wr == 0 && m == 0 && fr < 2)) *(u32x4*)(ACT + (size_t)row * FFD + cv) = pk;
            }
        asm volatile("s_waitcnt lgkmcnt(0)" ::: "memory"); __builtin_amdgcn_s_barrier(); asm volatile("" ::: "memory");
    }
};

template <class Epi, class Sched, bool ALIGN_EPI = false, bool SP2 = false>
__device__ __forceinline__ void gemm_phase(PG8_LAS unsigned char* lds, const Gemm g, const Sched& S, const Epi& E, const int tid  ) {
    const int wid = __builtin_amdgcn_readfirstlane(tid >> 6), lane = tid & 63, wr = wid >> 2, wc = wid & 3, fr = lane & 15, fq = lane >> 4;
    const int K = g.K, nt = K / BK;
    unsigned voffA[2], voffB[2];
#pragma unroll
    for (int i = 0; i < 2; ++i) { int R, C; stage_rc(tid * 16 + i * 8192, R, C); const int Rb = Epi::PERM ? ((R & ~31) + perm32(R & 31)) : R;
        voffA[i] = (unsigned)(R * K + C) * 2u; voffB[i] = (unsigned)(Rb * K + C) * 2u; }
    const size_t kstep = (size_t)(BK * 2);
    const size_t hstep = (size_t)HALF * K * 2;
    const size_t tstep = 2 * hstep;
    const unsigned ldsw = (unsigned)wid * 1024u;
    const int aoff = lds_byte(wr * 64 + fr, fq * 8), boff = lds_byte(wc * 32 + fr, fq * 8);
#define PG8_SA(b, h) (((b) * 2 + (h)) * HTB)
#define PG8_SB(b, h) ((4 + (b) * 2 + (h)) * HTB)
#define PG8_STAGE(bufoff, gbase, voff) do { _Pragma("unroll") for (int _i = 0; _i < 2; ++_i) \
        __builtin_amdgcn_global_load_lds((const unsigned*)((const char*)(gbase) + (voff)[_i]), (PG8_LAS unsigned*)(lds + (bufoff) + ldsw + _i * 8192), 16, 0, 0); } while (0)
#define PG8_LDA(dst, b, h) do { _Pragma("unroll") for (int m = 0; m < 4; ++m) _Pragma("unroll") for (int k = 0; k < 2; ++k) dst[m][k] = *(const PG8_LAS bf16x8*)(lds + PG8_SA(b, h) + aoff + m * 2048 + k * 1024); } while (0)
#define PG8_LDB(dst, b, h) do { _Pragma("unroll") for (int n = 0; n < 2; ++n) _Pragma("unroll") for (int k = 0; k < 2; ++k) dst[n][k] = *(const PG8_LAS bf16x8*)(lds + PG8_SB(b, h) + boff + n * 2048 + k * 1024); } while (0)
#define PG8_MMA(ai, bj, At, Bt) do { __builtin_amdgcn_s_setprio(1); _Pragma("unroll") for (int m = 0; m < 4; ++m) _Pragma("unroll") for (int n = 0; n < 2; ++n) _Pragma("unroll") for (int k = 0; k < 2; ++k) \
        acc[ai][bj][m][n] = __builtin_amdgcn_mfma_f32_16x16x32_bf16(Bt[n][k], At[m][k], acc[ai][bj][m][n], 0, 0, 0); __builtin_amdgcn_s_setprio(0); } while (0)
#define PG8_WAIT_V(n) asm volatile("s_waitcnt vmcnt(" #n ")" ::: "memory")
#define PG8_WAIT_L(n) asm volatile("s_waitcnt lgkmcnt(" #n ")" ::: "memory")
#define PG8_BAR __builtin_amdgcn_s_barrier()
#define PG8_SCHED __builtin_amdgcn_sched_barrier(0)
    Unit cur, nxt; int ui = 0;
    if (!S.next(0, cur)) return;
    f32x4 acc[2][2][4][2];
#pragma unroll
    for (int a = 0; a < 2; ++a)
#pragma unroll
        for (int b = 0; b < 2; ++b)
#pragma unroll
            for (int m = 0; m < 4; ++m)
#pragma unroll
                for (int n = 0; n < 2; ++n) acc[a][b][m][n] = (f32x4){0.f, 0.f, 0.f, 0.f};
    bf16x8 At[4][2], B0[2][2], B1[2][2];
    const char* cA = (const char*)g.A + (size_t)cur.pm * tstep; const char* cB = (const char*)g.Bt + (size_t)cur.pn * tstep;
    S.a_ready(cur);
    if constexpr (SP2) {
        PG8_STAGE(PG8_SB(0, 0), cB, voffB); PG8_STAGE(PG8_SB(0, 1), cB + hstep, voffB); PG8_STAGE(PG8_SA(0, 0), cA, voffA); PG8_STAGE(PG8_SA(0, 1), cA + hstep, voffA);
        if (wr == 1) PG8_BAR;
        PG8_WAIT_V(2); PG8_BAR;
        PG8_STAGE(PG8_SB(1, 0), cB + kstep, voffB); PG8_STAGE(PG8_SA(1, 0), cA + kstep, voffA); PG8_STAGE(PG8_SB(1, 1), cB + hstep + kstep, voffB);
        PG8_WAIT_V(6); PG8_BAR;
    } else {
        PG8_STAGE(PG8_SB(0, 0), cB, voffB); PG8_STAGE(PG8_SA(0, 0), cA, voffA); PG8_STAGE(PG8_SB(0, 1), cB + hstep, voffB); PG8_STAGE(PG8_SA(0, 1), cA + hstep, voffA);
        if (wr == 1) PG8_BAR;
        PG8_WAIT_V(4); PG8_BAR;
        PG8_STAGE(PG8_SB(1, 0), cB + kstep, voffB); PG8_STAGE(PG8_SA(1, 0), cA + kstep, voffA); PG8_STAGE(PG8_SB(1, 1), cB + hstep + kstep, voffB);
        PG8_WAIT_V(6); PG8_BAR;
    }
    for (;;) {
        const bool has_next = S.next(ui + 1, nxt);
        const char* nA = has_next ? (const char*)g.A + (size_t)nxt.pm * tstep : cA; const char* nB = has_next ? (const char*)g.Bt + (size_t)nxt.pn * tstep : cB;
        for (int t = 0; t < nt; t += 2) {
            const bool last = (t == nt - 2);
            const char* a1 = cA + (size_t)(t + 1) * kstep;
            const char* a2 = last ? nA : cA + (size_t)(t + 2) * kstep; const char* b2 = last ? nB : cB + (size_t)(t + 2) * kstep;
            const char* a3 = a2 + kstep; const char* b3 = b2 + kstep;
            if (last && has_next) S.a_ready(nxt);
            if constexpr (SP2) {
            PG8_LDB(B0, 0, 0); PG8_LDB(B1, 0, 1); PG8_SCHED; PG8_LDA(At, 0, 0); PG8_STAGE(PG8_SA(1, 1), a1 + hstep, voffA);
            PG8_WAIT_V(8); PG8_WAIT_L(0); PG8_BAR; PG8_MMA(0, 0, At, B0); PG8_MMA(0, 1, At, B1); PG8_BAR; PG8_SCHED;
            PG8_LDA(At, 0, 1); PG8_STAGE(PG8_SB(0, 0), b2, voffB); PG8_STAGE(PG8_SB(0, 1), b2 + hstep, voffB); PG8_STAGE(PG8_SA(0, 0), a2, voffA);
            PG8_WAIT_V(8); PG8_WAIT_L(0); PG8_BAR; PG8_MMA(1, 0, At, B0); PG8_MMA(1, 1, At, B1); PG8_BAR; PG8_SCHED;
            PG8_LDB(B0, 1, 0); PG8_LDB(B1, 1, 1); PG8_SCHED; PG8_LDA(At, 1, 0); PG8_STAGE(PG8_SA(0, 1), a2 + hstep, voffA);
            PG8_WAIT_V(8); PG8_WAIT_L(0); PG8_BAR; PG8_MMA(0, 0, At, B0); PG8_MMA(0, 1, At, B1); PG8_BAR; PG8_SCHED;
            PG8_LDA(At, 1, 1); PG8_STAGE(PG8_SB(1, 0), b3, voffB); PG8_STAGE(PG8_SB(1, 1), b3 + hstep, voffB); PG8_STAGE(PG8_SA(1, 0), a3, voffA);
            PG8_WAIT_V(8); PG8_WAIT_L(0); PG8_BAR; PG8_MMA(1, 0, At, B0); PG8_MMA(1, 1, At, B1); PG8_BAR; PG8_SCHED;
            } else {
            PG8_LDB(B0, 0, 0); PG8_SCHED; PG8_LDA(At, 0, 0); PG8_STAGE(PG8_SA(1, 1), a1 + hstep, voffA);
            PG8_WAIT_L(8); PG8_BAR; PG8_WAIT_L(0); PG8_MMA(0, 0, At, B0); PG8_BAR; PG8_SCHED;
            PG8_LDB(B1, 0, 1); PG8_STAGE(PG8_SB(0, 0), b2, voffB);
            PG8_BAR; PG8_WAIT_L(0); PG8_MMA(0, 1, At, B1); PG8_BAR;
            PG8_LDA(At, 0, 1); PG8_STAGE(PG8_SA(0, 0), a2, voffA);
            PG8_BAR; PG8_WAIT_L(0); PG8_MMA(1, 0, At, B0); PG8_BAR; PG8_SCHED;
            PG8_STAGE(PG8_SB(0, 1), b2 + hstep, voffB);
            PG8_WAIT_V(6); PG8_BAR; PG8_MMA(1, 1, At, B1); PG8_BAR;
            PG8_LDB(B0, 1, 0); PG8_SCHED; PG8_LDA(At, 1, 0); PG8_STAGE(PG8_SA(0, 1), a2 + hstep, voffA);
            PG8_WAIT_L(8); PG8_BAR; PG8_WAIT_L(0); PG8_MMA(0, 0, At, B0); PG8_BAR; PG8_SCHED;
            PG8_LDB(B1, 1, 1); PG8_STAGE(PG8_SB(1, 0), b3, voffB);
            PG8_BAR; PG8_WAIT_L(0); PG8_MMA(0, 1, At, B1); PG8_BAR;
            PG8_LDA(At, 1, 1); PG8_STAGE(PG8_SA(1, 0), a3, voffA);
            PG8_BAR; PG8_WAIT_L(0); PG8_MMA(1, 0, At, B0); PG8_BAR; PG8_SCHED;
            PG8_STAGE(PG8_SB(1, 1), b3 + hstep, voffB);
            PG8_WAIT_V(6); PG8_BAR; PG8_MMA(1, 1, At, B1); PG8_BAR;
            }
        }
        if constexpr (ALIGN_EPI) { if (wr == 0) PG8_BAR; }
        if constexpr (!Epi::AFTER_DRAIN) { E(acc, cur, wr, wc, fr, fq); S.done(cur); }
        if (!has_next) break;
#pragma unroll
        for (int a = 0; a < 2; ++a)
#pragma unroll
            for (int b = 0; b < 2; ++b)
#pragma unroll
                for (int m = 0; m < 4; ++m)
#pragma unroll
                    for (int n = 0; n < 2; ++n) acc[a][b][m][n] = (f32x4){0.f, 0.f, 0.f, 0.f};
        cur = nxt; cA = nA; cB = nB; ++ui;
        if constexpr (ALIGN_EPI) { if (wr == 1) PG8_BAR; }
    }
    PG8_WAIT_V(0);
    if constexpr (!ALIGN_EPI) { if (wr == 0) PG8_BAR; }
    PG8_BAR;
    if constexpr (Epi::AFTER_DRAIN) { E.fused(acc, cur, wr, wc, fr, fq, lds, wid, lane); S.done(cur); }
#undef PG8_SA
#undef PG8_SB
#undef PG8_STAGE
#undef PG8_LDA
#undef PG8_LDB
#undef PG8_MMA
#undef PG8_WAIT_V
#undef PG8_WAIT_L
#undef PG8_BAR
#undef PG8_SCHED
}
}

#define GAS __attribute__((address_space(1)))
#define LAS __attribute__((address_space(3)))
typedef unsigned short bf16;
typedef unsigned v4u __attribute__((ext_vector_type(4)));
typedef float f32x4 __attribute__((ext_vector_type(4)));
typedef short bf16x8 __attribute__((ext_vector_type(8)));
typedef GAS unsigned gu32;
typedef GAS unsigned long long gu64;
#define RLX_AGENT __ATOMIC_RELAXED, __HIP_MEMORY_SCOPE_AGENT
#define LDS_WAIT() asm volatile("s_waitcnt lgkmcnt(0)" ::: "memory")
#define VM_WAIT() asm volatile("s_waitcnt vmcnt(0)" ::: "memory")
__device__ __forceinline__ unsigned long long rt() { return __builtin_amdgcn_s_memrealtime(); }
__device__ __forceinline__ unsigned f2bf(float f) { unsigned u = __builtin_bit_cast(unsigned, f); return (u + 0x7fffu + ((u >> 16) & 1u)) >> 16; }
__device__ __forceinline__ unsigned pk2(float lo, float hi) { return f2bf(lo) | (f2bf(hi) << 16); }

#define XB_TMO      128
#define XB_XCNT(j)  (256  + 64 * (j))
#define XB_XSUB(j)  (1280 + 64 * (j))
#define XB_XGEN(j)  (2304 + 64 * (j))
#define XB_TOP      3328
#define XB_TOPGEN   3392
#define XCD_BAR_WORDS 3456
#define XB_SPIN_CAP (1u << 18)

__device__ __forceinline__ unsigned xb_ld(unsigned* p)              { return __hip_atomic_load(p, __ATOMIC_RELAXED, __HIP_MEMORY_SCOPE_AGENT); }
__device__ __forceinline__ unsigned xb_add(unsigned* p, unsigned v) { return __hip_atomic_fetch_add(p, v, __ATOMIC_RELAXED, __HIP_MEMORY_SCOPE_AGENT); }
__device__ __forceinline__ unsigned xb_xcc_id() { return (unsigned)__builtin_amdgcn_s_getreg((3 << 11) | 20) & 0xFu; }
#define XB_SPIN(cond, bar) do { unsigned _sp = 0; while (cond) { __builtin_amdgcn_s_sleep(1); \
    if ((++_sp & 255u) == 0u) { if (xb_ld(&(bar)[XB_TMO])) break; if (_sp > XB_SPIN_CAP) { atomicAdd(&(bar)[XB_TMO], 1u); break; } } } } while (0)

struct XcdBarrier {
    unsigned* bar; unsigned x;
    volatile LAS unsigned* st;
};

__device__ __forceinline__ XcdBarrier xcd_barrier_post(unsigned* bar, volatile LAS unsigned* st) {
    XcdBarrier b; b.bar = bar; b.x = xb_xcc_id(); b.st = st;
    if (threadIdx.x == 0) (void)xb_add(&bar[XB_XCNT(b.x)], 1u);
    return b;
}
__device__ __forceinline__ void xcd_barrier_complete(unsigned* bar, unsigned x, unsigned& nloc, unsigned& nx) {
    const unsigned G = gridDim.x * gridDim.y * gridDim.z;
    unsigned sum, cnt, mine, sp = 0u;
    for (;;) {
        sum = 0u; cnt = 0u; mine = 0u;
#pragma unroll
        for (unsigned j = 0; j < 16; ++j) { const unsigned c = xb_ld(&bar[XB_XCNT(j)]); sum += c; cnt += (c > 0u) ? 1u : 0u; mine = (j == x) ? c : mine; }
        if (sum == G) break;
        __builtin_amdgcn_s_sleep(1);
        if ((++sp & 255u) == 0u) { if (xb_ld(&bar[XB_TMO])) break; if (sp > XB_SPIN_CAP) { atomicAdd(&bar[XB_TMO], 1u); break; } }
    }
    nloc = mine > 0u ? mine : 1u; nx = cnt > 0u ? cnt : 1u;
}

__device__ __forceinline__ void xcd_barrier(const XcdBarrier& b) {
    asm volatile("s_waitcnt vmcnt(0)" ::: "memory");
    __syncthreads();
    if (threadIdx.x == 0) {
        unsigned* bar = b.bar;
        __builtin_amdgcn_s_waitcnt(0);
        unsigned nloc = b.st[0], nx = b.st[1];
        if (nloc == 0u) { xcd_barrier_complete(bar, b.x, nloc, nx); b.st[0] = nloc; b.st[1] = nx; }
        const unsigned old = xb_add(&bar[XB_XSUB(b.x)], 1u);
        const unsigned gen = old / nloc;
        if (old + 1u == (gen + 1u) * nloc) {
            __builtin_amdgcn_fence(__ATOMIC_RELEASE, "agent");
            asm volatile("s_waitcnt vmcnt(0)" ::: "memory");
            const unsigned og = xb_add(&bar[XB_TOP], 1u);
            const unsigned tg = og / nx;
            if (og + 1u == (tg + 1u) * nx) xb_add(&bar[XB_TOPGEN], 1u);
            else XB_SPIN(xb_ld(&bar[XB_TOPGEN]) == tg, bar);
            __builtin_amdgcn_fence(__ATOMIC_ACQUIRE, "agent");
            xb_add(&bar[XB_XGEN(b.x)], 1u);
            asm volatile("s_waitcnt vmcnt(0)" ::: "memory");
        } else {
            XB_SPIN(xb_ld(&bar[XB_XGEN(b.x)]) == gen, bar);
            __builtin_amdgcn_fence(__ATOMIC_ACQUIRE, "agent");
            asm volatile("s_waitcnt vmcnt(0)" ::: "memory");
        }
    }
    __syncthreads();
}

constexpr int NWAVES = 8;
constexpr int BATCH = 16, SEQ = 2048, D = 1024, M = BATCH * SEQ;
constexpr int SG = 64, SGS = 16, SP = 64;
constexpr int FFD = 2816, FF2 = 5632, AW = 3072, NH = 16, HD = 64, KVQW = 9216;
constexpr int MH = M / 2;
constexpr float DN_ALPHA = 1.4142135623730951f, LN_EPS = 1e-5f;
constexpr float QSCALE = 0.125f * 1.4426950408889634f;

constexpr size_t MiB = 1u << 20;
constexpr size_t WS_CTL = 0, CTL_ZERO_BYTES = 1 * MiB;
constexpr size_t WS_WGLU = 2 * MiB, WS_WOUT = 4 * MiB, WS_WUP0 = 6 * MiB, WS_WUP1 = 17 * MiB, WS_WDN0 = 28 * MiB, WS_WDN1 = 34 * MiB, WS_WKVQ = 40 * MiB, WS_WAO = 58 * MiB;
constexpr size_t WS_H16 = 64 * MiB, WS_Y16 = 128 * MiB, WS_BIG = 192 * MiB, WS_G16 = 368 * MiB, WS_HS = 432 * MiB, WS_RAW = 480 * MiB, WS_S5T = 492 * MiB, WS_END = 512 * MiB;
static_assert(WS_WUP0 + (size_t)FF2 * D * 2 <= WS_WUP1 && WS_WDN0 + (size_t)D * FFD * 2 <= WS_WDN1 && WS_WDN1 + (size_t)D * FFD * 2 <= WS_WKVQ && WS_WKVQ + (size_t)KVQW * D * 2 <= WS_WAO && WS_WAO + 2 * MiB <= WS_H16, "weights map");
static_assert(WS_BIG + (size_t)MH * KVQW * 2 <= WS_RAW && WS_BIG + (size_t)M * FFD * 2 <= WS_G16 && WS_RAW + (size_t)128 * 4 * FF2 * 4 <= WS_S5T, "activation map");
constexpr int CW_BAR = 4096;
constexpr int MAX_LAUNCHES = 8;

constexpr int RING_OFF = 0, RING_BYTES = 131072;
constexpr int XCH_OFF = RING_BYTES, XCH_BYTES = 8192;
constexpr int LDSCTL_OFF = XCH_OFF + XCH_BYTES, MISC_OFF = LDSCTL_OFF + 320;
constexpr int LDS_BYTES = 147456;
static_assert(MISC_OFF + 128 <= LDS_BYTES, "LDS map");

__device__ const unsigned char BUCKET[3][129] = {
{0,1,2,3,4,5,6,7,8,9,10,11,12,13,14,15,16,16,16,16,16,16,17,17,17,17,17,17,17,17,18,18,18,18,18,18,18,18,18,18,19,19,19,19,19,19,19,19,19,19,19,19,19,19,20,20,20,20,20,20,20,20,20,20,20,20,20,20,20,20,20,20,20,21,21,21,21,21,21,21,21,21,21,21,21,21,21,21,21,21,21,21,21,21,21,21,21,21,21,22,22,22,22,22,22,22,22,22,22,22,22,22,22,22,22,22,22,22,22,22,22,22,22,22,22,22,22,22,22},
{0,4,8,12,16,16,17,17,18,18,19,19,19,19,20,20,20,20,20,21,21,21,21,21,21,22,22,22,22,22,22,22,22,22,23,23,23,23,23,23,23,23,23,23,23,23,24,24,24,24,24,24,24,24,24,24,24,24,24,24,24,24,25,25,25,25,25,25,25,25,25,25,25,25,25,25,25,25,25,25,25,25,25,26,26,26,26,26,26,26,26,26,26,26,26,26,26,26,26,26,26,26,26,26,26,26,26,26,26,26,26,26,26,27,27,27,27,27,27,27,27,27,27,27,27,27,27,27,27},
{0,16,18,19,20,21,21,22,22,23,23,23,24,24,24,24,25,25,25,25,25,26,26,26,26,26,26,26,26,27,27,27,27,27,27,27,27,27,27,28,28,28,28,28,28,28,28,28,28,28,28,28,29,29,29,29,29,29,29,29,29,29,29,29,29,29,29,29,29,29,30,30,30,30,30,30,30,30,30,30,30,30,30,30,30,30,30,30,30,30,30,30,30,30,30,31,31,31,31,31,31,31,31,31,31,31,31,31,31,31,31,31,31,31,31,31,31,31,31,31,31,31,31,31,31,31,31,31,31}};

__device__ __forceinline__ double d_exp_small(double x) {
    double y = x * 0.125, t = 1.0, s = 1.0;
#pragma unroll
    for (int i = 1; i <= 14; ++i) { t *= y / (double)i; s += t; }
    s *= s; s *= s; s *= s; return s;
}
__device__ __forceinline__ void d_sincos(double x, double& sn, double& cs) {
    const double TWO_PI = 6.283185307179586476925286766559;
    const double k = __builtin_rint(x / TWO_PI); const double r = x - k * TWO_PI;
    const double q = r * 0.25, q2 = q * q;
    double s = 0.0, c = 0.0, ts = q, tc = 1.0;
#pragma unroll
    for (int i = 0; i < 10; ++i) { s += ts; c += tc; ts *= -q2 / (double)((2 * i + 2) * (2 * i + 3)); tc *= -q2 / (double)((2 * i + 1) * (2 * i + 2)); }
#pragma unroll
    for (int i = 0; i < 2; ++i) { const double s2 = 2.0 * s * c, c2 = c * c - s * s; s = s2; c = c2; }
    sn = s; cs = c;
}
__device__ __forceinline__ float gelu_tanh(float v) { const float z2 = 1.5957691216057308f * (v + 0.044715f * v * v * v); return v * __builtin_amdgcn_rcpf(1.0f + __expf(-z2)); }
__device__ __forceinline__ float wave_sum(float v) {
#pragma unroll
    for (int o = 1; o < 64; o <<= 1) v += __shfl_xor(v, o);
    return v;
}

struct Ptrs {
    const float* in[22]; float* out; unsigned char* ws;
};
__device__ __forceinline__ void p0_transpose_item(const float* W, int K, int N, bf16* WT, int drow0, LAS float* scr, int kb, int nb, int lane) {
    const int k0 = 64 * kb, n0 = 32 * nb;
#pragma unroll 8
    for (int i = 0; i < 32; ++i) { const int kk = 2 * i + (lane >> 5); scr[kk * 33 + (lane & 31)] = W[(size_t)(k0 + kk) * N + n0 + (lane & 31)]; }
    LDS_WAIT(); asm volatile("" ::: "memory");
    const int c = lane & 7;
#pragma unroll
    for (int j = 0; j < 4; ++j) { const int n = (lane >> 3) + 8 * j; const LAS float* s = scr + (8 * c) * 33 + n;
        v4u o; o.x = pk2(s[0 * 33], s[1 * 33]); o.y = pk2(s[2 * 33], s[3 * 33]); o.z = pk2(s[4 * 33], s[5 * 33]); o.w = pk2(s[6 * 33], s[7 * 33]);
        *(GAS v4u*)(WT + (size_t)(drow0 + n) * K + k0 + 8 * c) = o; }
    LDS_WAIT(); asm volatile("" ::: "memory");
}
template <bool UPMAP> __device__ __forceinline__ bool p0_matrix(int& it, const float* W, int K, int N, bf16* WT, int drow_off, LAS float* scr, int lane) {
    const int nblk = N / 32, items = (K / 64) * nblk;
    if (it >= items) { it -= items; return false; }
    const int kb = it / nblk, nb = it % nblk; int drow0 = drow_off + 32 * nb;
    if (UPMAP) { const int n0 = 32 * nb, hh = n0 / FFD, cc = n0 % FFD; drow0 = 256 * (cc / 128) + 128 * hh + (cc % 128); }
    p0_transpose_item(W, K, N, WT, drow0, scr, kb, nb, lane); return true;
}
__device__ __forceinline__ void p0_prologue(const Ptrs& P, LAS unsigned char* lds, int gw, int NGW, int wave, int lane) {
    LAS float* scr = (LAS float*)(lds + RING_OFF + wave * 16384);
    unsigned char* ws = P.ws;
    constexpr int I_DD = 16 * 32, I_UP = 16 * 176, I_DN = 44 * 32, I_KV = 16 * 192, I_Q = 16 * 96;
    constexpr int NITEMS = 3 * I_DD + 2 * I_UP + 2 * I_DN + I_KV + I_Q;
    for (int it0 = gw; it0 < NITEMS; it0 += NGW) {
        int it = it0;
        if (p0_matrix<false>(it, P.in[9], D, D, (bf16*)(ws + WS_WGLU), 0, scr, lane)) continue;
        if (p0_matrix<false>(it, P.in[11], D, D, (bf16*)(ws + WS_WOUT), 0, scr, lane)) continue;
        if (p0_matrix<true>(it, P.in[16], D, FF2, (bf16*)(ws + WS_WUP0), 0, scr, lane)) continue;
        if (p0_matrix<true>(it, P.in[16] + (size_t)D * FF2, D, FF2, (bf16*)(ws + WS_WUP1), 0, scr, lane)) continue;
        if (p0_matrix<false>(it, P.in[19], FFD, D, (bf16*)(ws + WS_WDN0), 0, scr, lane)) continue;
        if (p0_matrix<false>(it, P.in[19] + (size_t)FFD * D, FFD, D, (bf16*)(ws + WS_WDN1), 0, scr, lane)) continue;
        if (p0_matrix<false>(it, P.in[12], D, 2 * AW, (bf16*)(ws + WS_WKVQ), 0, scr, lane)) continue;
        if (p0_matrix<false>(it, P.in[13], D, AW, (bf16*)(ws + WS_WKVQ), 2 * AW, scr, lane)) continue;
        p0_matrix<false>(it, P.in[14], D, D, (bf16*)(ws + WS_WAO), 0, scr, lane);
    }
}

namespace s5 {
typedef float f32x16 __attribute__((ext_vector_type(16)));
constexpr size_t T_TK = 0, T_TS = 2 * MiB, T_TO = 10 * MiB, T_TA = 18 * MiB;
__device__ __forceinline__ void disc(const Ptrs& P, int g, int p, double& ar, double& ai, double& cor, double& coi) {
    const double dth = d_exp_small((double)P.in[3][g] * 0.5), dt = dth * dth;
    const double lr = P.in[1][g * SP + p], li = P.in[2][g * SP + p];
    ar = lr * dt; ai = li * dt;
    const double mag = d_exp_small(ar); double sn, cs; d_sincos(ai, sn, cs);
    const double abr = mag * cs, abi = mag * sn, den = lr * lr + li * li, nr = abr - 1.0;
    cor = (nr * lr + abi * li) / den; coi = (abi * lr - nr * li) / den;
}
__device__ __forceinline__ void cpow(double ar, double ai, int k, double& pr, double& pi) { const double mag = d_exp_small((double)k * ar); double sn, cs; d_sincos((double)k * ai, sn, cs); pr = mag * cs; pi = mag * sn; }

__device__ __forceinline__ void tables(const Ptrs& P, LAS unsigned char* lds, int gw, int NGW, int wave, int lane) {
    unsigned char* tb = P.ws + WS_S5T;
    bf16* TK = (bf16*)(tb + T_TK); bf16* TS = (bf16*)(tb + T_TS); bf16* TO = (bf16*)(tb + T_TO); float* TA = (float*)(tb + T_TA);
    LAS float* scr = (LAS float*)(lds + RING_OFF + wave * 16384);
    for (int it = gw; it < SG * 32; it += NGW) {
        const int g = it >> 5, k = it & 31, p = lane;
        double ar, ai, cor, coi; disc(P, g, p, ar, ai, cor, coi);
        double pr, pi; cpow(ar, ai, k, pr, pi);
        const float zr = (float)(pr * cor - pi * coi), zi = (float)(pr * coi + pi * cor);
        float br[16], bi[16];
#pragma unroll
        for (int h = 0; h < 16; ++h) { const float b_r = P.in[4][(g * SP + p) * 16 + h], b_i = P.in[5][(g * SP + p) * 16 + h]; br[h] = zr * b_r - zi * b_i; bi[h] = zr * b_i + zi * b_r; }
        for (int ho = 0; ho < 16; ++ho) {
            const float cr = P.in[6][(g * 16 + ho) * SP + p], ci = P.in[7][(g * 16 + ho) * SP + p];
#pragma unroll
            for (int h = 0; h < 16; ++h) { float v = wave_sum(cr * br[h] - ci * bi[h]); if (k == 0 && h == ho) v += P.in[8][g * 16 + ho]; if (lane == 0) scr[ho * 16 + h] = v; }
        }
        LDS_WAIT(); asm volatile("" ::: "memory");
#pragma unroll
        for (int q = 0; q < 4; ++q) { const int v = lane + 64 * q, ho = v >> 4, hi = v & 15; const bf16 val = (bf16)f2bf(scr[v]);
            if (k <= 30) TK[(((size_t)g * 32 + (k + 1)) * 64 + (ho + 32 * (hi >> 3))) * 8 + (hi & 7)] = val;
            TK[(((size_t)g * 32 + k) * 64 + (16 + ho + 32 * (hi >> 3))) * 8 + (hi & 7)] = val;
            if (k == 0) TK[(((size_t)g * 32 + 0) * 64 + (ho + 32 * (hi >> 3))) * 8 + (hi & 7)] = 0; }
        LDS_WAIT(); asm volatile("" ::: "memory");
    }
    const int gt = gw * 64 + lane, NGT = NGW * 64;
    for (int it = gt; it < SG * 4 * 32 * 64; it += NGT) {
        const int l2 = it & 63, j = (it >> 6) & 31, rt = (it >> 11) & 3, g = it >> 13;
        const int R = 32 * rt + (l2 & 31), ri = R >> 6, p = R & 63;
        double ar, ai, cor, coi; disc(P, g, p, ar, ai, cor, coi);
        double pr, pi; cpow(ar, ai, 31 - j, pr, pi);
        const double zr = pr * cor - pi * coi, zi = pr * coi + pi * cor;
        unsigned w[4];
#pragma unroll
        for (int q = 0; q < 4; ++q) { float v[2];
#pragma unroll
            for (int e = 0; e < 2; ++e) { const int hi = 8 * (l2 >> 5) + 2 * q + e; const double b_r = P.in[4][(g * SP + p) * 16 + hi], b_i = P.in[5][(g * SP + p) * 16 + hi];
                v[e] = (float)(ri == 0 ? zr * b_r - zi * b_i : zr * b_i + zi * b_r); }
            w[q] = pk2(v[0], v[1]); }
        *(v4u*)(TS + (size_t)it * 8) = (v4u){w[0], w[1], w[2], w[3]};
    }
    for (int it = gt; it < SG * 16 * 8 * 64; it += NGT) {
        const int l2 = it & 63, ks = (it >> 6) & 7, rt = (it >> 9) & 15, g = it >> 13;
        const int row = l2 & 31, ii = row >> 4, ho = row & 15, i = 2 * rt + ii;
        float v[8];
#pragma unroll
        for (int jj = 0; jj < 8; ++jj) { const int R = 16 * ks + 8 * (l2 >> 5) + jj, ri = R >> 6, p = R & 63;
            double ar, ai, cor, coi; disc(P, g, p, ar, ai, cor, coi);
            double pr, pi; cpow(ar, ai, i + 1, pr, pi);
            const double cr = P.in[6][(g * 16 + ho) * SP + p], ci = P.in[7][(g * 16 + ho) * SP + p];
            v[jj] = (float)(ri == 0 ? cr * pr - ci * pi : -(cr * pi + ci * pr)); }
        *(v4u*)(TO + (size_t)it * 8) = (v4u){pk2(v[0], v[1]), pk2(v[2], v[3]), pk2(v[4], v[5]), pk2(v[6], v[7])};
    }
    for (int it = gt; it < SG * SP; it += NGT) { double ar, ai, cor, coi; disc(P, it >> 6, it & 63, ar, ai, cor, coi); double pr, pi; cpow(ar, ai, 32, pr, pi); TA[2 * it] = (float)pr; TA[2 * it + 1] = (float)pi; }
}

__device__ __forceinline__ bf16x8 load_u(const float* xp) { const f32x4 a = *(const f32x4*)xp, b = *(const f32x4*)(xp + 4); const v4u w = {pk2(a[0], a[1]), pk2(a[2], a[3]), pk2(b[0], b[1]), pk2(b[2], b[3])}; return __builtin_bit_cast(bf16x8, w); }

__device__ __forceinline__ void phase_a(const Ptrs& P, float* HS, int vcu, int wave, int lane) {
    const int g = 8 * (vcu & 7) + wave, bh = vcu >> 3, b = bh >> 1, half = bh & 1, cc = lane & 31, hk = lane >> 5, c = half * 32 + cc;
    const bf16* TS = (const bf16*)(P.ws + WS_S5T + T_TS) + (size_t)g * 4 * 32 * 64 * 8 + lane * 8;
    const float* xp = P.in[0] + ((size_t)(b * SEQ + 32 * c)) * D + 16 * g + 8 * hk;
    f32x16 acc[4] = {};
#pragma unroll 4
    for (int j = 0; j < 32; ++j) {
        const bf16x8 u = load_u(xp + (size_t)j * D);
#pragma unroll
        for (int rt = 0; rt < 4; ++rt) acc[rt] = __builtin_amdgcn_mfma_f32_32x32x16_bf16(*(const bf16x8*)(TS + ((size_t)rt * 32 + j) * 512), u, acc[rt], 0, 0, 0);
    }
    float* hp = HS + (((size_t)(b * SG + g)) * 64 + c) * 128 + 4 * hk;
#pragma unroll
    for (int rt = 0; rt < 4; ++rt)
#pragma unroll
        for (int qd = 0; qd < 4; ++qd) *(f32x4*)(hp + 32 * rt + 8 * qd) = (f32x4){acc[rt][4 * qd], acc[rt][4 * qd + 1], acc[rt][4 * qd + 2], acc[rt][4 * qd + 3]};
}

__device__ __forceinline__ void phase_b(const Ptrs& P, float* HS, int vcu, int tid) {
    if (tid >= 256) return;
    const int idx = vcu * 256 + tid, b = idx >> 12, g = (idx >> 6) & 63, p = idx & 63;
    const float* TA = (const float*)(P.ws + WS_S5T + T_TA); const float ar = TA[2 * (g * SP + p)], ai = TA[2 * (g * SP + p) + 1];
    float* hp = HS + ((size_t)(b * SG + g)) * 64 * 128 + p;
    float hr = 0.f, hi = 0.f;
    for (int c0 = 0; c0 < 64; c0 += 16) {
        float sr[16], si[16];
#pragma unroll
        for (int i = 0; i < 16; ++i) { sr[i] = hp[(size_t)(c0 + i) * 128]; si[i] = hp[(size_t)(c0 + i) * 128 + 64]; }
#pragma unroll
        for (int i = 0; i < 16; ++i) { hp[(size_t)(c0 + i) * 128] = hr; hp[(size_t)(c0 + i) * 128 + 64] = hi;
            const float nr = ar * hr - ai * hi + sr[i], ni = ar * hi + ai * hr + si[i]; hr = nr; hi = ni; }
    }
}

__device__ __forceinline__ void phase_c(const Ptrs& P, const float* HS, bf16* Y, int vcu, int wave, int lane) {
    const int g = 8 * (vcu & 7) + wave, bh = vcu >> 3, b = bh >> 1, half = bh & 1, cc = lane & 31, hk = lane >> 5, c = half * 32 + cc;
    const bf16* TK = (const bf16*)(P.ws + WS_S5T + T_TK) + (size_t)g * 32 * 512 + lane * 8;
    const bf16* TO = (const bf16*)(P.ws + WS_S5T + T_TO) + (size_t)g * 16 * 8 * 512 + lane * 8;
    const float* xp = P.in[0] + ((size_t)(b * SEQ + 32 * c)) * D + 16 * g + 8 * hk;
    const float* hp = HS + (((size_t)(b * SG + g)) * 64 + c) * 128 + 8 * hk;
    bf16x8 U[32], H[8];
#pragma unroll
    for (int j = 0; j < 32; ++j) U[j] = load_u(xp + (size_t)j * D);
#pragma unroll
    for (int ks = 0; ks < 8; ++ks) H[ks] = load_u(hp + 16 * ks);
    bf16* yp = Y + ((size_t)(b * SEQ + 32 * c)) * D + 16 * g + 4 * hk;
#pragma unroll
    for (int rt = 0; rt < 16; ++rt) {
        f32x16 acc = {};
#pragma unroll
        for (int j = 0; j < 2 * rt + 2; ++j) acc = __builtin_amdgcn_mfma_f32_32x32x16_bf16(*(const bf16x8*)(TK + (size_t)(2 * rt - j + 1) * 512), U[j], acc, 0, 0, 0);
#pragma unroll
        for (int ks = 0; ks < 8; ++ks) acc = __builtin_amdgcn_mfma_f32_32x32x16_bf16(*(const bf16x8*)(TO + (size_t)(rt * 8 + ks) * 512), H[ks], acc, 0, 0, 0);
#pragma unroll
        for (int qd = 0; qd < 4; ++qd) {
            const unsigned w0 = pk2(gelu_tanh(acc[4 * qd]), gelu_tanh(acc[4 * qd + 1])), w1 = pk2(gelu_tanh(acc[4 * qd + 2]), gelu_tanh(acc[4 * qd + 3]));
            *(unsigned long long*)(yp + (size_t)(2 * rt + (qd >> 1)) * D + 8 * (qd & 1)) = (unsigned long long)w0 | ((unsigned long long)w1 << 32); }
        asm volatile("" ::: "memory");
    }
}
}

__device__ __forceinline__ void ln_phase(float* Z, float* Zd, const float* gain, const float* bias, bf16* H16, int gw, int NGW, int lane) {
    constexpr int RI = 4;
    f32x4 gv[4], bv[4];
#pragma unroll
    for (int j = 0; j < 4; ++j) { gv[j] = *(const f32x4*)(gain + 4 * lane + 256 * j); bv[j] = *(const f32x4*)(bias + 4 * lane + 256 * j); }
    for (int m0 = gw; m0 < M; m0 += RI * NGW) {
        f32x4 v[RI][4];
#pragma unroll
        for (int i = 0; i < RI; ++i) { GAS f32x4* zr = (GAS f32x4*)(Z + (size_t)(m0 + i * NGW) * D) + lane;
#pragma unroll
            for (int j = 0; j < 4; ++j) v[i][j] = zr[64 * j]; }
#pragma unroll
        for (int i = 0; i < RI; ++i) { const int m = m0 + i * NGW;
            float s = 0.f;
#pragma unroll
            for (int j = 0; j < 4; ++j) s += (v[i][j].x + v[i][j].y) + (v[i][j].z + v[i][j].w);
            const float mean = wave_sum(s) * (1.f / D); float s2 = 0.f;
#pragma unroll
            for (int j = 0; j < 4; ++j) { v[i][j] = v[i][j] - mean; s2 += (v[i][j].x * v[i][j].x + v[i][j].y * v[i][j].y) + (v[i][j].z * v[i][j].z + v[i][j].w * v[i][j].w); }
            const float rstd = 1.f / sqrtf(wave_sum(s2) * (1.f / D) + LN_EPS);
            GAS f32x4* zw = (GAS f32x4*)(Zd + (size_t)m * D) + lane;
#pragma unroll
            for (int j = 0; j < 4; ++j) { v[i][j] = v[i][j] * rstd * gv[j] + bv[j]; zw[64 * j] = v[i][j]; }
            if (H16) { GAS unsigned long long* o8 = (GAS unsigned long long*)(H16 + (size_t)m * D) + lane;
#pragma unroll
                for (int j = 0; j < 4; ++j) o8[64 * j] = (unsigned long long)pk2(v[i][j].x, v[i][j].y) | ((unsigned long long)pk2(v[i][j].z, v[i][j].w) << 32); }
        }
    }
}

__device__ __forceinline__ void fixup_phase(const float* RAW, const float* cw, const float* cb, bf16* ACT, int gt, int NGT) {
    for (int i = gt; i < 128 * 2 * FFD; i += NGT) {
        const int pm = i / (2 * FFD), j = (i / FFD) & 1, c = i % FFD;
        if ((pm & 7) == 0) continue;
        const int nv = 256 * (c / 128) + (c % 128), ng = nv + 128;
        const float* r0 = RAW + (size_t)(pm * 4) * FF2; const float* rp = RAW + (size_t)((pm - 1) * 4) * FF2;
        float val, gate;
        if (j == 0) { val = cb[c] + cw[c] * r0[nv] + cw[FF2 + c] * rp[3 * FF2 + nv] + cw[2 * FF2 + c] * rp[2 * FF2 + nv];
                      gate = cb[FFD + c] + cw[FFD + c] * r0[ng] + cw[FF2 + FFD + c] * rp[3 * FF2 + ng] + cw[2 * FF2 + FFD + c] * rp[2 * FF2 + ng]; }
        else { val = cb[c] + cw[c] * r0[FF2 + nv] + cw[FF2 + c] * r0[nv] + cw[2 * FF2 + c] * rp[3 * FF2 + nv];
               gate = cb[FFD + c] + cw[FFD + c] * r0[FF2 + ng] + cw[FF2 + FFD + c] * r0[ng] + cw[2 * FF2 + FFD + c] * rp[3 * FF2 + ng]; }
        ACT[(size_t)(pm * 256 + j) * FFD + c] = (bf16)f2bf(gate * __builtin_amdgcn_rcpf(1.0f + __expf(-gate)) * val);
    }
}

namespace att {
typedef float f32x16 __attribute__((ext_vector_type(16)));
typedef short s16x4 __attribute__((ext_vector_type(4)));
typedef short v4i16_t __attribute__((ext_vector_type(4)));
typedef float f32x2_t __attribute__((ext_vector_type(2))); typedef __bf16 bf16x2_t __attribute__((ext_vector_type(2)));
constexpr float LOG2E = 1.4426950408889634f;
constexpr int A_PO = 0, A_PL = 65536, A_BT = 67584, A_WV = 69888, WV_STRIDE = 4608, A_END = A_WV + 8 * WV_STRIDE;
static_assert(A_END <= RING_BYTES, "attention LDS map");
__device__ __forceinline__ int crow(int r, int hi) { return (r & 3) + 8 * (r >> 2) + 4 * hi; }
__device__ __forceinline__ unsigned cvtpk_s(float lo, float hi) { f32x2_t v = {lo, hi}; bf16x2_t b = __builtin_convertvector(v, bf16x2_t); return __builtin_bit_cast(unsigned, b); }
__device__ __forceinline__ s16x4 vtr(LAS unsigned char* p) { return __builtin_bit_cast(s16x4, __builtin_amdgcn_ds_read_tr16_b64_v4i16((LAS v4i16_t*)p)); }
__device__ __forceinline__ float swap_max(float v) { auto rr = __builtin_amdgcn_permlane32_swap(__float_as_uint(v), __float_as_uint(v), false, false); return fmaxf(__uint_as_float(rr[0]), __uint_as_float(rr[1])); }
__device__ __forceinline__ float swap_add(float v) { auto rr = __builtin_amdgcn_permlane32_swap(__float_as_uint(v), __float_as_uint(v), false, false); return __uint_as_float(rr[0]) + __uint_as_float(rr[1]); }

__device__ __forceinline__ void attn_qtile(const bf16* __restrict__ KVQ, bf16* __restrict__ Og, LAS unsigned char* lds, int b, int h, int g, int dil, int r, int s0, int t0, int wave, int lane) {
    const int r32 = lane & 31, hi = lane >> 5;
    const size_t rowb = (size_t)b * SEQ;
    LAS unsigned char* wv = lds + A_WV + wave * WV_STRIDE;
    LAS unsigned char* vbuf = wv;
    LAS float* wsf = (LAS float*)(wv + 4096);
    const LAS float* bt = (const LAS float*)(lds + A_BT) + g * 192;
    bf16x8 qr[4];
    const int nsl = SEQ / dil;
    const bf16* Kb = KVQ + ((size_t)(((0 * 3 + g) * 8 + b) * 16 + h) * SEQ + (size_t)r * nsl) * 64;
    constexpr size_t VOFF = (size_t)3 * 8 * 16 * SEQ * 64;
    { const bf16* qrow = Kb + 2 * VOFF + (size_t)(s0 + r32) * 64 + hi * 8;
#pragma unroll
      for (int d0 = 0; d0 < 4; ++d0) qr[d0] = *(const bf16x8*)(qrow + d0 * 16); }
    f32x16 o0 = {}, o1 = {}; float m = 0.f, l = 0.f;
    const int jmin = s0 >= 128 ? 0 : (128 - s0) / 32;
    const LAS unsigned char* vrd = vbuf + ((lane >> 4) & 1) * 32 + (lane & 3) * 8 + (4 * hi + ((lane & 15) >> 2)) * 64;
    const bf16* kbase = Kb + (ptrdiff_t)(s0 - 128 + r32) * 64 + hi * 8;
    const bf16* vbase = Kb + VOFF + (ptrdiff_t)(s0 - 128 + (lane >> 3)) * 64 + (lane & 7) * 8;
    const size_t tstep = (size_t)32 * 64, v8 = (size_t)8 * 64;
    bf16x8 kn[4]; v4u vn[4];
#pragma unroll
    for (int d0 = 0; d0 < 4; ++d0) kn[d0] = *(const bf16x8*)(kbase + jmin * tstep + d0 * 16);
#pragma unroll
    for (int i = 0; i < 4; ++i) vn[i] = *(const v4u*)(vbase + jmin * tstep + i * v8);
    for (int j = jmin; j < 5; ++j) {
        bf16x8 kf[4]; v4u vv[4];
#pragma unroll
        for (int d0 = 0; d0 < 4; ++d0) kf[d0] = kn[d0];
#pragma unroll
        for (int i = 0; i < 4; ++i) vv[i] = vn[i];
        if (j + 1 < 5) {
#pragma unroll
            for (int d0 = 0; d0 < 4; ++d0) kn[d0] = *(const bf16x8*)(kbase + (j + 1) * tstep + d0 * 16);
#pragma unroll
            for (int i = 0; i < 4; ++i) vn[i] = *(const v4u*)(vbase + (j + 1) * tstep + i * v8);
        }
#pragma unroll
        for (int i = 0; i < 4; ++i) *(LAS v4u*)(vbuf + ((lane & 7) >> 2) * 2048 + (8 * i + (lane >> 3)) * 64 + (lane & 3) * 16) = vv[i];
        f32x16 p = {};
#pragma unroll
        for (int d0 = 0; d0 < 4; ++d0) p = __builtin_amdgcn_mfma_f32_32x32x16_bf16(kf[d0], qr[d0], p, 0, 0, 0);
        const LAS float* btl = bt + ((128 - 32 * j) + 32 + r32 - 4 * hi - 27);
        float mt = -1e30f;
#pragma unroll
        for (int rr = 0; rr < 16; ++rr) { p[rr] += btl[27 - ((rr & 3) + 8 * (rr >> 2))]; mt = fmaxf(mt, p[rr]); }
        mt = swap_max(mt);
        if (j == jmin) m = mt;
        else if (__any(mt > m + 8.0f)) {
            const float mn = fmaxf(m, mt), f = __builtin_amdgcn_exp2f(m - mn); m = mn; l *= f;
            if (hi == 0) wsf[r32] = f;
#pragma unroll
            for (int rr = 0; rr < 16; ++rr) { const float fr_ = wsf[crow(rr, hi)]; o0[rr] *= fr_; o1[rr] *= fr_; }
        }
        float sum = 0.f;
#pragma unroll
        for (int rr = 0; rr < 16; ++rr) { p[rr] = __builtin_amdgcn_exp2f(p[rr] - m); sum += p[rr]; }
        l += sum;
        v4u pw0, pw1;
        pw0.x = cvtpk_s(p[0], p[1]); pw0.y = cvtpk_s(p[2], p[3]); pw0.z = cvtpk_s(p[4], p[5]); pw0.w = cvtpk_s(p[6], p[7]);
        pw1.x = cvtpk_s(p[8], p[9]); pw1.y = cvtpk_s(p[10], p[11]); pw1.z = cvtpk_s(p[12], p[13]); pw1.w = cvtpk_s(p[14], p[15]);
#pragma unroll
        for (int ks = 0; ks < 2; ++ks) {
            const bf16x8 pa = __builtin_bit_cast(bf16x8, ks == 0 ? pw0 : pw1);
            { const s16x4 lo = vtr((LAS unsigned char*)vrd + ks * 1024), hh = vtr((LAS unsigned char*)vrd + ks * 1024 + 512);
              const bf16x8 vf = {lo[0], lo[1], lo[2], lo[3], hh[0], hh[1], hh[2], hh[3]};
              o0 = __builtin_amdgcn_mfma_f32_32x32x16_bf16(pa, vf, o0, 0, 0, 0); }
            { const s16x4 lo = vtr((LAS unsigned char*)vrd + 2048 + ks * 1024), hh = vtr((LAS unsigned char*)vrd + 2048 + ks * 1024 + 512);
              const bf16x8 vf = {lo[0], lo[1], lo[2], lo[3], hh[0], hh[1], hh[2], hh[3]};
              o1 = __builtin_amdgcn_mfma_f32_32x32x16_bf16(pa, vf, o1, 0, 0, 0); }
        }
    }
    l = swap_add(l);
    if (hi == 0) { wsf[r32] = __builtin_amdgcn_rcpf(l); wsf[32 + r32] = m + __builtin_amdgcn_logf(l); }
    bf16* stg = (bf16*)vbuf; LAS bf16* stg3 = (LAS bf16*)vbuf;
#pragma unroll
    for (int rr = 0; rr < 16; ++rr) { const int orow = crow(rr, hi); const float rl = wsf[orow];
        stg3[orow * 64 + r32] = (bf16)f2bf(o0[rr] * rl); stg3[orow * 64 + 32 + r32] = (bf16)f2bf(o1[rr] * rl); }
    (void)stg;
    LAS unsigned char* PO = lds + A_PO; LAS float* PL = (LAS float*)(lds + A_PL);
#pragma unroll
    for (int i = 0; i < 4; ++i) {
        const int row = i * 8 + (lane >> 3), ch = lane & 7;
        const v4u v = *(const LAS v4u*)(vbuf + row * 128 + ch * 16);
        const int pos = (s0 + row) * dil + r - t0;
        const float ls = wsf[32 + row];
        if (g == 0) { *(LAS v4u*)(PO + pos * 128 + ch * 16) = v; if (ch == 0) PL[pos] = ls; }
        else {
            const v4u pv = *(const LAS v4u*)(PO + pos * 128 + ch * 16); const float pl = PL[pos];
            const float mx = fmaxf(pl, ls), nl = mx + __builtin_amdgcn_logf(__builtin_amdgcn_exp2f(pl - mx) + __builtin_amdgcn_exp2f(ls - mx));
            const float wp = __builtin_amdgcn_exp2f(pl - nl), w1 = __builtin_amdgcn_exp2f(ls - nl);
            v4u o;
            o.x = cvtpk_s(wp * __uint_as_float(pv.x << 16) + w1 * __uint_as_float(v.x << 16), wp * __uint_as_float(pv.x & 0xffff0000u) + w1 * __uint_as_float(v.x & 0xffff0000u));
            o.y = cvtpk_s(wp * __uint_as_float(pv.y << 16) + w1 * __uint_as_float(v.y << 16), wp * __uint_as_float(pv.y & 0xffff0000u) + w1 * __uint_as_float(v.y & 0xffff0000u));
            o.z = cvtpk_s(wp * __uint_as_float(pv.z << 16) + w1 * __uint_as_float(v.z << 16), wp * __uint_as_float(pv.z & 0xffff0000u) + w1 * __uint_as_float(v.z & 0xffff0000u));
            o.w = cvtpk_s(wp * __uint_as_float(pv.w << 16) + w1 * __uint_as_float(v.w << 16), wp * __uint_as_float(pv.w & 0xffff0000u) + w1 * __uint_as_float(v.w & 0xffff0000u));
            if (g == 1) { *(LAS v4u*)(PO + pos * 128 + ch * 16) = o; if (ch == 0) PL[pos] = nl; }
            else *(v4u*)(Og + (rowb + t0 + pos) * D + h * 64 + ch * 8) = o;
        }
    }
}

__device__ __forceinline__ void attn_phase(const bf16* KVQ, bf16* Og  , const float* rel_bias, LAS unsigned char* lds, int vcu, int tid) {
    const int lane = tid & 63, wave = __builtin_amdgcn_readfirstlane(tid >> 6);
    const int bh = vcu >> 1, b = bh >> 4, h = bh & 15, sub = vcu & 1;
    if (bh >= (MH / SEQ) * NH) return;
    for (int i = tid; i < 3 * 192; i += NWAVES * 64) { const int g = i / 192, st = i % 192 - 32;
        ((LAS float*)(lds + A_BT))[i] = (st >= 0 && st <= 128) ? rel_bias[BUCKET[g][st] * 48 + g * 16 + h] * LOG2E : -1e30f; }
    __syncthreads();
    for (int ui = 0; ui < 2; ++ui) {
        const int blk = ui == 0 ? (sub == 0 ? 0 : 1) : (sub == 0 ? 3 : 2), t0 = blk * 512;
        for (int g = 0; g < 3; ++g) {
            const int dil = g == 0 ? 1 : (g == 1 ? 4 : 16), tpr = 16 / dil;
            for (int qi = 0; qi < 2; ++qi) {
                const int qt = wave + 8 * qi, r = qt / tpr, jj = qt % tpr, s0 = t0 / dil + 32 * jj;
                attn_qtile(KVQ, Og, lds, b, h, g, dil, r, s0, t0, wave, lane);
            }
            __syncthreads();
        }
    }
}
}

struct Args { const float* in[22]; float* out; unsigned char* ws; int ph_lo, ph_hi, li, pad; };
enum { PH_PRO = 0, PH_S5A, PH_S5B, PH_S5C, PH_GLU, PH_OUT, PH_LN0, PH_UP0, PH_FIX0, PH_DN0, PH_LN1, PH_KVQ0, PH_ATT0, PH_KVQ1, PH_ATT1, PH_AO, PH_LN2, PH_UP1, PH_FIX1, PH_DN1, PH_LN3, N_PHASES };
__global__ void __launch_bounds__(NWAVES * 64, 2) mk_fwd(Args args) {
    extern __shared__ __attribute__((aligned(16))) unsigned char lds_raw[];
    LAS unsigned char* lds = (LAS unsigned char*)lds_raw;
    volatile LAS unsigned* MISC = (volatile LAS unsigned*)(lds + MISC_OFF);
    const int G = gridDim.x, bx = blockIdx.x, vcu = (G % 8 == 0) ? (bx % 8) * (G / 8) + bx / 8 : bx;
    Ptrs P;
#pragma unroll
    for (int i = 0; i < 22; ++i) P.in[i] = args.in[i];
    P.out = args.out; P.ws = args.ws;
    unsigned char* ws = args.ws;
    gu32* ctl = (gu32*)(ws + WS_CTL);
    for (int u = threadIdx.x; u < (LDS_BYTES - LDSCTL_OFF) / 4; u += NWAVES * 64) ((LAS unsigned*)(lds + LDSCTL_OFF))[u] = 0u;
    __syncthreads();
    XcdBarrier bar = xcd_barrier_post((unsigned*)(ctl + CW_BAR) + args.li * XCD_BAR_WORDS, MISC + 8);
    bf16* H16 = (bf16*)(ws + WS_H16); bf16* Y16 = (bf16*)(ws + WS_Y16); bf16* G16 = (bf16*)(ws + WS_G16); bf16* ACT = (bf16*)(ws + WS_BIG); bf16* KVQ = (bf16*)(ws + WS_BIG);
    float* RAW = (float*)(ws + WS_RAW); float* HS = (float*)(ws + WS_HS); float* out = args.out;
    const float* ln_g = args.in[20]; const float* ln_b = args.in[21];

#ifndef PROBE_MASK
#define PROBE_MASK 0u
#endif
    for (int ph = args.ph_lo; ph < args.ph_hi; ++ph) {
      const int nrep = ((PROBE_MASK >> ph) & 1u) ? 2 : 1;
      for (int rep = 0; rep < nrep; ++rep) {
        float* dummy = (float*)(ws + ((ph == PH_DN0 || ph == PH_DN1) ? 368 * MiB : WS_BIG));
        int tid = threadIdx.x; asm volatile("" : "+v"(tid));
        const int lane = tid & 63, wave = __builtin_amdgcn_readfirstlane(tid >> 6);
        const int gw = vcu * NWAVES + wave, NGW = G * NWAVES, gt = vcu * (NWAVES * 64) + tid, NGT = G * NWAVES * 64;
        if (ph == PH_PRO) { p0_prologue(P, lds, gw, NGW, wave, lane); s5::tables(P, lds, gw, NGW, wave, lane); }
        else if (ph == PH_S5A) s5::phase_a(P, HS, vcu, wave, lane);
        else if (ph == PH_S5B) { if (rep > 0) { s5::phase_a(P, HS, vcu, wave, lane); xcd_barrier(bar); } s5::phase_b(P, HS, vcu, tid); }
        else if (ph == PH_S5C) s5::phase_c(P, HS, Y16, vcu, wave, lane);
        else if (ph == PH_GLU) {
            pg8::Gemm g{Y16, (const bf16*)(ws + WS_WGLU), M, D, D}; pg8::StaticOrder S; S.init(M, D, G, bx);
            pg8::EpiGlu E{Y16, args.in[10], G16, D};
            pg8::gemm_phase<pg8::EpiGlu, pg8::StaticOrder, true, true>(lds + RING_OFF, g, S, E, tid);
        } else if (ph == PH_OUT || ph == PH_DN0 || ph == PH_AO || ph == PH_DN1) {
            const bf16* A = ph == PH_OUT ? G16 : (ph == PH_AO ? Y16 : ACT);
            const bf16* Bt = (const bf16*)(ws + (ph == PH_OUT ? WS_WOUT : ph == PH_DN0 ? WS_WDN0 : ph == PH_AO ? WS_WAO : WS_WDN1));
            const int K = (ph == PH_DN0 || ph == PH_DN1) ? FFD : D;
            pg8::Gemm g{A, Bt, M, D, K}; pg8::StaticOrder S; S.init(M, D, G, bx);
            pg8::EpiRes E{ph == PH_OUT ? args.in[0] : out, rep > 0 ? dummy : out, D, DN_ALPHA};
            pg8::gemm_phase<pg8::EpiRes, pg8::StaticOrder, true, true>(lds + RING_OFF, g, S, E, tid);
        } else if (ph == PH_LN0 || ph == PH_LN1 || ph == PH_LN2 || ph == PH_LN3) {
            const int li = ph == PH_LN0 ? 0 : ph == PH_LN1 ? 1 : ph == PH_LN2 ? 2 : 3;
            ln_phase(out, (nrep > 1 && rep == 0) ? dummy : out, ln_g + li * D, ln_b + li * D, ph == PH_LN3 ? (bf16*)nullptr : H16, gw, NGW, lane);
        } else if (ph == PH_UP0 || ph == PH_UP1) {
            const int layer = ph == PH_UP0 ? 0 : 1;
            pg8::Gemm g{H16, (const bf16*)(ws + (layer ? WS_WUP1 : WS_WUP0)), M, FF2, D}; pg8::StaticOrder S; S.init(M, FF2, G, bx);
            pg8::EpiConvGate E{ACT, args.in[17] + (size_t)layer * 3 * FF2, args.in[18] + (size_t)layer * FF2, RAW, (PG8_LAS float*)(lds + XCH_OFF)};
            pg8::gemm_phase<pg8::EpiConvGate, pg8::StaticOrder, true, true>(lds + RING_OFF, g, S, E, tid);
        } else if (ph == PH_FIX0 || ph == PH_FIX1) {
            const int layer = ph == PH_FIX0 ? 0 : 1;
            fixup_phase(RAW, args.in[17] + (size_t)layer * 3 * FF2, args.in[18] + (size_t)layer * FF2, ACT, gt, NGT);
        } else if (ph == PH_KVQ0 || ph == PH_KVQ1) {
            const int half = ph == PH_KVQ0 ? 0 : 1;
            pg8::Gemm g{H16 + (size_t)half * MH * D, (const bf16*)(ws + WS_WKVQ), MH, KVQW, D}; pg8::StaticOrder S; S.init(MH, KVQW, G, bx);
            pg8::EpiKVQ E{KVQ, QSCALE};
            pg8::gemm_phase<pg8::EpiKVQ, pg8::StaticOrder, true, true>(lds + RING_OFF, g, S, E, tid);
        } else if (ph == PH_ATT0 || ph == PH_ATT1) {
            att::attn_phase(KVQ, Y16 + (size_t)(ph == PH_ATT0 ? 0 : 1) * MH * D, args.in[15], lds + RING_OFF, vcu, tid);
        }
        if (ph + 1 < args.ph_hi || rep + 1 < nrep) xcd_barrier(bar);
      }
    }
}

extern "C" void kernel_launch(void* const* d_in, const int* in_sizes, int n_in, void* d_out, int out_size, void* d_ws, size_t ws_size, hipStream_t stream) {
    static int grid = 0;
    if (grid == 0) {
        if (n_in != 22 || in_sizes[0] != M * D || out_size != M * D || ws_size < WS_END) { fprintf(stderr, "kernel_launch: unexpected shapes / workspace (%d inputs, ws %zu)\n", n_in, ws_size); grid = -1; return; }
        int dev = 0, cus = 0, per_cu = 0;
        if (hipGetDevice(&dev) != hipSuccess || hipDeviceGetAttribute(&cus, hipDeviceAttributeMultiprocessorCount, dev) != hipSuccess) { grid = -1; return; }
        if (hipFuncSetAttribute((const void*)mk_fwd, hipFuncAttributeMaxDynamicSharedMemorySize, LDS_BYTES) != hipSuccess) { grid = -1; return; }
        if (hipOccupancyMaxActiveBlocksPerMultiprocessor(&per_cu, (const void*)mk_fwd, NWAVES * 64, LDS_BYTES) != hipSuccess || per_cu < 1) fprintf(stderr, "kernel_launch: occupancy query reports %d\n", per_cu);
        (void)hipGetLastError();
        grid = cus;
        if (grid != 256) fprintf(stderr, "kernel_launch: %d CUs; the unit schedule expects 256\n", grid);
    }
    if (grid < 0) return;
    if (hipMemsetAsync((char*)d_ws + WS_CTL, 0, CTL_ZERO_BYTES, stream) != hipSuccess) return;
    Args a{};
    for (int i = 0; i < 22; ++i) a.in[i] = (const float*)d_in[i];
    a.out = (float*)d_out; a.ws = (unsigned char*)d_ws;
#ifndef MK_CUTS
#define MK_CUTS {0, N_PHASES}
#endif
    const int cuts[] = MK_CUTS; const int nl = (int)(sizeof(cuts) / sizeof(int)) - 1;
    for (int li = 0; li < nl; ++li) {
        a.ph_lo = cuts[li]; a.ph_hi = cuts[li + 1]; a.li = li;
        hipLaunchKernelGGL(mk_fwd, dim3(grid), dim3(NWAVES * 64), LDS_BYTES, stream, a);
    }
}
```
